# Optimizing an MI355X kernel written in HIP

```python
import math
import jax, jax.numpy as jnp
from jax import lax
import numpy as np

D_MODEL = 1024
BATCH = 8
SEQ = 2048
DEPTH = 1
DEC_BATCH = 128
DEC_SEQ = 1
PAST_LEN = 16384
PAGE_SIZE = 128

GLA_HEADS = 4
GLA_DK = 128
GLA_DV = 256
GLA_RANK = 16
GLA_TAU = 16.0
HGRN_HEADS = 8
HGRN_EXPAND = 128
HGRN_DV = 128
CHUNK = 64
DEEPNORM_ALPHA = (2.0 * DEPTH) ** 0.25
DEEPNORM_BETA = (8.0 * DEPTH) ** -0.25
NORM_EPS = 1e-5

GLA_K = GLA_HEADS * GLA_DK
GLA_V = GLA_HEADS * GLA_DV
HGRN_K = HGRN_HEADS * HGRN_EXPAND
HGRN_V = HGRN_HEADS * HGRN_DV
SPLITS = (GLA_K, GLA_K, GLA_V, GLA_V, GLA_RANK, HGRN_K, HGRN_K, HGRN_V, HGRN_V, D_MODEL, D_MODEL)
IN_DIM = int(sum(SPLITS))
SPLIT_POINTS = [int(s) for s in np.cumsum(SPLITS)[:-1]]

kernel_name = "gla_hgrn2_parallel_gated_deepnorm_step"


def _chunk_gated_linear(q, k, v, log_decay, s0):
    f32 = jnp.float32
    B, T, H, DK = q.shape
    DV = v.shape[-1]
    C = min(CHUNK, T)
    n = -(-T // C)
    pad = n * C - T
    q, k, v, log_decay = (a.astype(f32) for a in (q, k, v, log_decay))
    if pad > 0:
        cfg = ((0, 0), (0, pad), (0, 0), (0, 0))
        q, k, v, log_decay = (jnp.pad(a, cfg) for a in (q, k, v, log_decay))

    def to_chunks(a):
        d = a.shape[-1]
        return a.reshape(B, n, C, H, d).transpose(1, 0, 3, 2, 4)

    qc, kc, vc, gc = to_chunks(q), to_chunks(k), to_chunks(v), to_chunks(log_decay)
    mask = jnp.tril(jnp.ones((C, C), dtype=bool))

    def step(S, inp):
        qb, kb, vb, gb = inp
        b = jnp.cumsum(gb, axis=2)
        o_inter = jnp.einsum('bhtk,bhkv->bhtv', qb * jnp.exp(b), S)
        diff = b[:, :, :, None, :] - b[:, :, None, :, :]
        decay = jnp.exp(jnp.where(mask[None, None, :, :, None], diff, -jnp.inf))
        scores = jnp.einsum('bhtk,bhsk,bhtsk->bhts', qb, kb, decay)
        o_intra = jnp.einsum('bhts,bhsv->bhtv', scores, vb)
        b_last = b[:, :, -1:, :]
        S_new = jnp.exp(b_last[:, :, 0, :])[..., None] * S + jnp.einsum(
            'bhsk,bhsv->bhkv', kb * jnp.exp(b_last - b), vb)
        return S_new, o_inter + o_intra

    s_final, o = lax.scan(step, s0.astype(f32), (qc, kc, vc, gc))
    o = o.transpose(1, 0, 3, 2, 4).reshape(B, n * C, H, DV)[:, :T]
    return o, s_final


def _head_rmsnorm(o, g):
    o = o * lax.rsqrt(jnp.mean(o * o, axis=-1, keepdims=True) + NORM_EPS)
    return o * g.astype(jnp.float32)


def _mixer_layer(x, s_gla, s_hgrn, w_in, w_gate_lr, b_gate_lr, gla_norm_g, w_br_gla,
                 lb, hgrn_norm_g, w_br_hgrn, w_out, ln_g, ln_b):
    f32 = jnp.float32
    B, T, _ = x.shape
    h = jnp.einsum('btd,de->bte', x, w_in)
    gq, gk, gv, gr, ga, hq, hf, hi, hr, mg_a, mg_b = jnp.split(h, SPLIT_POINTS, axis=-1)

    q = gq.astype(f32).reshape(B, T, GLA_HEADS, GLA_DK) * (GLA_DK ** -0.5)
    k = gk.astype(f32).reshape(B, T, GLA_HEADS, GLA_DK)
    v = gv.astype(f32).reshape(B, T, GLA_HEADS, GLA_DV)
    a_logit = jnp.einsum('btr,rk->btk', ga, w_gate_lr) + b_gate_lr
    log_alpha = jax.nn.log_sigmoid(a_logit.astype(f32)).reshape(B, T, GLA_HEADS, GLA_DK) / GLA_TAU
    o_a, s_gla_new = _chunk_gated_linear(q, k, v, log_alpha, s_gla)
    o_a = _head_rmsnorm(o_a, gla_norm_g).reshape(B, T, GLA_V).astype(x.dtype) * jax.nn.silu(gr)
    p_a = jnp.einsum('btv,vd->btd', o_a, w_br_gla)

    qh = jax.nn.silu(hq.astype(f32)).reshape(B, T, HGRN_HEADS, HGRN_EXPAND)
    lbf = lb.astype(f32)
    hf32 = hf.astype(f32)
    f = lbf + (1.0 - lbf) * jax.nn.sigmoid(hf32)
    log_f = jnp.log(f).reshape(B, T, HGRN_HEADS, HGRN_EXPAND)
    kh = ((1.0 - lbf) * jax.nn.sigmoid(-hf32)).reshape(B, T, HGRN_HEADS, HGRN_EXPAND)
    ih = hi.astype(f32).reshape(B, T, HGRN_HEADS, HGRN_DV)
    o_b, s_hgrn_new = _chunk_gated_linear(qh, kh, ih, log_f, s_hgrn)
    o_b = _head_rmsnorm(o_b, hgrn_norm_g).reshape(B, T, HGRN_V).astype(x.dtype) * jax.nn.silu(hr)
    p_b = jnp.einsum('btv,vd->btd', o_b, w_br_hgrn)

    merged = jax.nn.sigmoid(mg_a) * p_a + jax.nn.sigmoid(mg_b) * p_b
    y = jnp.einsum('btd,de->bte', merged, w_out)

    z = (DEEPNORM_ALPHA * x + y).astype(f32)
    mu = jnp.mean(z, axis=-1, keepdims=True)
    zc = z - mu
    var = jnp.mean(zc * zc, axis=-1, keepdims=True)
    out = zc * lax.rsqrt(var + NORM_EPS) * ln_g.astype(f32) + ln_b.astype(f32)
    return out.astype(x.dtype), s_gla_new.astype(s_gla.dtype), s_hgrn_new.astype(s_hgrn.dtype)


def setup_inputs(seed: int = 0) -> dict:
    key = jax.random.key(seed)
    ks = jax.random.split(key, 16)
    f32 = jnp.float32
    nrm = lambda k, shape, s: (jax.random.normal(k, shape, f32) * s)
    return {
        "x_prompt": nrm(ks[0], (BATCH, SEQ, D_MODEL), 1.0),
        "x_sample": nrm(ks[1], (DEC_BATCH, DEC_SEQ, D_MODEL), 1.0),
        "state_gla": nrm(ks[2], (DEPTH, DEC_BATCH, GLA_HEADS, GLA_DK, GLA_DV), 1.0),
        "state_hgrn": nrm(ks[3], (DEPTH, DEC_BATCH, HGRN_HEADS, HGRN_EXPAND, HGRN_DV), 0.5),
        "w_in": nrm(ks[4], (DEPTH, D_MODEL, IN_DIM), D_MODEL ** -0.5),
        "w_gate_lr": nrm(ks[5], (DEPTH, GLA_RANK, GLA_K), GLA_RANK ** -0.5),
        "b_gate_lr": nrm(ks[6], (DEPTH, GLA_K), 0.1),
        "gla_norm_g": 1.0 + nrm(ks[7], (DEPTH, GLA_HEADS, GLA_DV), 0.02),
        "w_br_gla": nrm(ks[8], (DEPTH, GLA_V, D_MODEL), DEEPNORM_BETA * GLA_V ** -0.5),
        "hgrn_lb_param": nrm(ks[9], (DEPTH + 1, HGRN_K), 0.1),
        "hgrn_norm_g": 1.0 + nrm(ks[10], (DEPTH, HGRN_HEADS, HGRN_DV), 0.02),
        "w_br_hgrn": nrm(ks[11], (DEPTH, HGRN_V, D_MODEL), DEEPNORM_BETA * HGRN_V ** -0.5),
        "w_out": nrm(ks[12], (DEPTH, D_MODEL, D_MODEL), DEEPNORM_BETA * D_MODEL ** -0.5),
        "ln_g": 1.0 + nrm(ks[13], (DEPTH, D_MODEL), 0.02),
        "ln_b": nrm(ks[14], (DEPTH, D_MODEL), 0.02),
    }


def reference(x_prompt, x_sample, state_gla, state_hgrn, w_in, w_gate_lr, b_gate_lr,
              gla_norm_g, w_br_gla, hgrn_lb_param, hgrn_norm_g, w_br_hgrn, w_out, ln_g, ln_b):
    lb_all = jnp.cumsum(jax.nn.softmax(hgrn_lb_param.astype(jnp.float32), axis=0), axis=0)
    yp, ys = x_prompt, x_sample
    gla_p, hgrn_p, gla_s, hgrn_s = [], [], [], []
    for l in range(DEPTH):
        weights = (w_in[l], w_gate_lr[l], b_gate_lr[l], gla_norm_g[l], w_br_gla[l], lb_all[l],
                   hgrn_norm_g[l], w_br_hgrn[l], w_out[l], ln_g[l], ln_b[l])
        s0_gla = jnp.zeros((yp.shape[0], GLA_HEADS, GLA_DK, GLA_DV), state_gla.dtype)
        s0_hgrn = jnp.zeros((yp.shape[0], HGRN_HEADS, HGRN_EXPAND, HGRN_DV), state_hgrn.dtype)
        yp, sg_p, sh_p = _mixer_layer(yp, s0_gla, s0_hgrn, *weights)
        ys, sg_s, sh_s = _mixer_layer(ys, state_gla[l], state_hgrn[l], *weights)
        gla_p.append(sg_p)
        hgrn_p.append(sh_p)
        gla_s.append(sg_s)
        hgrn_s.append(sh_s)
    new_gla_prompt = jnp.stack(gla_p, axis=0)
    new_hgrn_prompt = jnp.stack(hgrn_p, axis=0)
    new_gla_sample = jnp.stack(gla_s, axis=0)
    new_hgrn_sample = jnp.stack(hgrn_s, axis=0)
    return (yp, ys, new_gla_prompt, new_hgrn_prompt, new_gla_sample, new_hgrn_sample)
```

```cpp
#include <hip/hip_runtime.h>
#include <hip/hip_fp16.h>
#include <hip/hip_cooperative_groups.h>
#include <cstdio>
namespace cg = cooperative_groups;

#define DI __device__ __forceinline__
typedef __attribute__((ext_vector_type(8))) short bf16x8;
typedef __attribute__((ext_vector_type(4))) float f32x4;
typedef __attribute__((ext_vector_type(4))) unsigned u32x4;
typedef __attribute__((ext_vector_type(2))) unsigned u32x2;
typedef unsigned short bf16_t;

constexpr int D = 1024;
constexpr int TP = 16384;
constexpr int TS = 128;
constexpr int TT = TP + TS;
constexpr int SEQ = 2048;
constexpr int IN_DIM = 9232;
constexpr int N1 = 5248;
constexpr int N2 = 4096;
constexpr int NTOT = N1 + N2;
constexpr int LDH1 = 5120;
constexpr int LDH2 = 2048;
constexpr float ALPHA = 1.189207115002721f;
constexpr float EPS = 1e-5f;

constexpr size_t OFF_Y = 0;
constexpr size_t OFF_GLA_P = (size_t)TT * D;
constexpr size_t OFF_HGRN_P = OFF_GLA_P + (size_t)8 * 4 * 128 * 256;
constexpr size_t OFF_GLA_S = OFF_HGRN_P + (size_t)8 * 8 * 128 * 128;
constexpr size_t OFF_HGRN_S = OFF_GLA_S + (size_t)128 * 4 * 128 * 256;

constexpr size_t WS_H1 = 0;
constexpr size_t WS_H2 = 0;
constexpr size_t WS_MG = (size_t)TT * 2048 * 2;
constexpr size_t WS_AD = WS_MG + (size_t)TT * 1024 * 2;
static_assert(WS_AD + (size_t)TT * 2048 * 2 <= (size_t)TT * LDH1 * 2, "AD overlay");
constexpr size_t WS_XB = (size_t)TT * LDH1 * 2;
constexpr size_t WS_WIN = WS_XB + (size_t)TT * D * 2;
constexpr size_t WS_WD = WS_WIN + (size_t)NTOT * D * 2;
constexpr size_t WS_WO = WS_WD + (size_t)D * 2048 * 2;
constexpr size_t WS_GA = WS_WO + (size_t)D * D * 2;
constexpr size_t WS_SSQ = WS_GA + (size_t)TT * 16 * 4;
constexpr size_t WS_LF = WS_SSQ + (size_t)TT * 64 * 4;
constexpr size_t WS_END = WS_LF + (size_t)TT * D * 2;
static_assert(WS_END <= (size_t)256 * 1024 * 1024, "workspace too large");

constexpr int XCD_BAR_WORDS_C = 3456;
constexpr int HALF_SMEM = 77824;
constexpr int SMEM_BYTES = 2 * HALF_SMEM;

struct Params {
  const float* x_prompt; const float* x_sample; const float* state_gla; const float* state_hgrn;
  const float* w_in; const float* w_gate_lr; const float* b_gate_lr; const float* gla_norm_g;
  const float* w_br_gla; const float* lb_param; const float* hgrn_norm_g; const float* w_br_hgrn;
  const float* w_out; const float* ln_g; const float* ln_b;
  float* out; char* ws;
};

typedef __bf16 bf16x2_t __attribute__((ext_vector_type(2)));
typedef float f32x2_t __attribute__((ext_vector_type(2)));
DI unsigned pack2(float lo, float hi) { f32x2_t v = {lo, hi}; bf16x2_t b = __builtin_convertvector(v, bf16x2_t); return __builtin_bit_cast(unsigned, b); }
DI float bflo(unsigned u) { return __uint_as_float(u << 16); }
DI float bfhi(unsigned u) { return __uint_as_float(u & 0xffff0000u); }
DI float bf2f(bf16_t h) { return __uint_as_float((unsigned)h << 16); }
DI float sigmoidf(float x) { return __builtin_amdgcn_rcpf(1.0f + __expf(-x)); }
DI float siluf(float x) { return x * __builtin_amdgcn_rcpf(1.0f + __expf(-x)); }
DI float logsigf(float x) { return fminf(x, 0.f) - __logf(1.0f + __expf(-fabsf(x))); }
DI int opaque_tid() { int t = threadIdx.x; asm volatile("" : "+v"(t)); return t; }
DI const char* sp_(const char* p) { asm volatile("" : "+s"(p)); return p; }
DI char* sp_(char* p) { asm volatile("" : "+s"(p)); return p; }
DI u32x4 pack8(f32x4 a, f32x4 b) { u32x4 w; w[0] = pack2(a[0], a[1]); w[1] = pack2(a[2], a[3]); w[2] = pack2(b[0], b[1]); w[3] = pack2(b[2], b[3]); return w; }
DI void lds_barrier() { asm volatile("s_waitcnt lgkmcnt(0)" ::: "memory"); __builtin_amdgcn_s_barrier(); asm volatile("" ::: "memory"); }
template <int CTRL> DI float dpp_f(float x) { return __int_as_float(__builtin_amdgcn_mov_dpp(__float_as_int(x), CTRL, 0xf, 0xf, true)); }
DI float row16_sum(float s) {
  s += dpp_f<0x128>(s);
  s += dpp_f<0x124>(s);
  s += dpp_f<0x122>(s);
  s += dpp_f<0x121>(s);
  return s;
}
#define MFMA16(a, b, c) __builtin_amdgcn_mfma_f32_16x16x32_bf16((a), (b), (c), 0, 0, 0)

DI int wcol_map(int n) {
  if (n < 2048) return n;
  if (n < 5120) return n + 1040;
  if (n < 5136) return 3072 + (n - 5120);
  if (n < 5248) return -1;
  if (n < 6272) return 2048 + (n - 5248);
  if (n < 7296) return 6160 + (n - 6272);
  return 7184 + (n - 7296);
}

DI void transpose_tile(const float* __restrict__ src, int lds_, int k0, int n0, bool use_map,
                       bf16_t* __restrict__ dst, int ldd, int dk0, float* sT, int tid, bool valid) {
  if (valid) {
    const int c4 = (tid & 15) * 4, r0 = tid >> 4;
    const int col = use_map ? wcol_map(n0 + c4) : (n0 + c4);
    f32x4 v[4];
#pragma unroll
    for (int i = 0; i < 4; ++i) v[i] = (col >= 0) ? *(const f32x4*)(src + (size_t)(k0 + r0 + i * 16) * lds_ + col) : (f32x4){0.f, 0.f, 0.f, 0.f};
#pragma unroll
    for (int i = 0; i < 4; ++i) *(f32x4*)(sT + (r0 + i * 16) * 68 + c4) = v[i];
  }
  lds_barrier();
  if (valid) {
    const int kc = (tid & 7) * 8, n_0 = tid >> 3;
#pragma unroll
    for (int i = 0; i < 2; ++i) {
      const int n = n_0 + i * 32;
      u32x4 w;
#pragma unroll
      for (int e = 0; e < 4; ++e) w[e] = pack2(sT[(kc + 2 * e) * 68 + n], sT[(kc + 2 * e + 1) * 68 + n]);
      *(u32x4*)(dst + (size_t)(n0 + n) * ldd + dk0 + k0 + kc) = w;
    }
  }
  lds_barrier();
}

DI void phase_convert(const Params& p, char* smem_all) {
  const int tid_all = opaque_tid();
  const int half = __builtin_amdgcn_readfirstlane(tid_all >> 8), tid = tid_all & 255;
  bf16_t* xb = (bf16_t*)(p.ws + WS_XB);
  const size_t nvec = (size_t)TT * D / 8;
  const size_t stride = (size_t)gridDim.x * 512;
  for (size_t i0 = (size_t)blockIdx.x * 512 + tid_all; i0 < nvec; i0 += 4 * stride) {
    f32x4 a[4], b[4];
#pragma unroll
    for (int j = 0; j < 4; ++j) {
      const size_t i = i0 + j * stride;
      if (i < nvec) {
        const size_t e = i * 8;
        const float* s = (e < (size_t)TP * D) ? (p.x_prompt + e) : (p.x_sample + (e - (size_t)TP * D));
        a[j] = *(const f32x4*)s; b[j] = *(const f32x4*)(s + 4);
      }
    }
#pragma unroll
    for (int j = 0; j < 4; ++j) {
      const size_t i = i0 + j * stride;
      if (i < nvec) *(u32x4*)(xb + i * 8) = pack8(a[j], b[j]);
    }
  }
  float* sT = (float*)(smem_all + half * HALF_SMEM);
  bf16_t* win = (bf16_t*)(p.ws + WS_WIN);
  bf16_t* wd = (bf16_t*)(p.ws + WS_WD);
  bf16_t* wo = (bf16_t*)(p.ws + WS_WO);
  constexpr int T_IN = 16 * (NTOT / 64);
  constexpr int T_SQ = 16 * 16;
  const int total = T_IN + 3 * T_SQ;
  const int G2 = gridDim.x * 2;
  for (int t0 = 0; t0 < total; t0 += G2) {
    int t = t0 + blockIdx.x * 2 + half;
    const bool valid = t < total;
    if (!valid) t = total - 1;
    if (t < T_IN) {
      int kt = t & 15, nt = t >> 4;
      transpose_tile(p.w_in, IN_DIM, kt * 64, nt * 64, true, win, D, 0, sT, tid, valid);
    } else {
      int u = t - T_IN; int which = u / T_SQ; u -= which * T_SQ;
      int kt = u & 15, nt = u >> 4;
      const float* s = (which == 0) ? p.w_br_gla : ((which == 1) ? p.w_br_hgrn : p.w_out);
      bf16_t* d = (which == 2) ? wo : wd;
      transpose_tile(s, D, kt * 64, nt * 64, false, d, (which == 2) ? D : 2048, (which == 1) ? 1024 : 0, sT, tid, valid);
    }
  }
}

struct PlainLoader {
  const bf16_t* base; int ld; u32x4 r[4];
  DI void issue(int kt, int tid) {
    const unsigned loff = (unsigned)((tid >> 3) * ld + (tid & 7) * 8) * 2u;
    const char* kb = (const char*)base + (size_t)kt * 128;
#pragma unroll
    for (int i = 0; i < 4; ++i) r[i] = *(const u32x4*)(kb + (size_t)i * 32 * ld * 2 + loff);
  }
  DI u32x4 get(int i, int tid) const { return r[i]; }
};

template <bool ZERO, class LA>
DI void gemm128(char* smem, int kt0, int nk, LA& la, PlainLoader& lb, f32x4 (&acc)[4][4], int tid) {
  const int lane = tid & 63, wave = tid >> 6, wm = wave >> 1, wn = wave & 1;
  const int r = lane & 15, q4 = lane >> 4;
  char* sA = smem; char* sB = smem + 32768;
  if (ZERO) {
#pragma unroll
    for (int i = 0; i < 4; ++i)
#pragma unroll
      for (int j = 0; j < 4; ++j) acc[i][j] = (f32x4){0.f, 0.f, 0.f, 0.f};
  }
  la.issue(kt0, tid); lb.issue(kt0, tid);
const int woff = (tid >> 3) * 128 + (((tid & 7) ^ ((tid >> 3) & 7)) << 4);
#pragma unroll
  for (int i = 0; i < 4; ++i) { *(u32x4*)(sA + woff + i * 4096) = la.get(i, tid); *(u32x4*)(sB + woff + i * 4096) = lb.get(i, tid); }
  lds_barrier();
  for (int kt = 0; kt < nk; ++kt) {
    const int buf = kt & 1;
    if (kt + 1 < nk) { la.issue(kt0 + kt + 1, tid); lb.issue(kt0 + kt + 1, tid); }
    const char* cA = sA + buf * 16384 + (wm * 64 + r) * 128;
    const char* cB = sB + buf * 16384 + (wn * 64 + r) * 128;
#pragma unroll
    for (int ks = 0; ks < 2; ++ks) {
      const int sw = ((ks * 4 + q4) ^ (r & 7)) << 4;
      bf16x8 af[4], bfr[4];
#pragma unroll
      for (int i = 0; i < 4; ++i) { af[i] = *(const bf16x8*)(cA + i * 2048 + sw); bfr[i] = *(const bf16x8*)(cB + i * 2048 + sw); }
#pragma unroll
      for (int i = 0; i < 4; ++i)
#pragma unroll
        for (int j = 0; j < 4; ++j) acc[i][j] = MFMA16(bfr[j], af[i], acc[i][j]);
    }
    if (kt + 1 < nk) {
      const int nb = buf ^ 1;
#pragma unroll
      for (int i = 0; i < 4; ++i) { *(u32x4*)(sA + nb * 16384 + woff + i * 4096) = la.get(i, tid); *(u32x4*)(sB + nb * 16384 + woff + i * 4096) = lb.get(i, tid); }
    }
    lds_barrier();
  }
}


DI void gemm128p(char* smem, int kt0, int nk, PlainLoader (&la)[2], PlainLoader (&lb)[2], f32x4 (&acc)[4][4], int tid) {
  const int lane = tid & 63, wave = tid >> 6, wm = wave >> 1, wn = wave & 1;
  const int r = lane & 15, q4 = lane >> 4;
  char* sA = smem; char* sB = smem + 32768;
#pragma unroll
  for (int i = 0; i < 4; ++i)
#pragma unroll
    for (int j = 0; j < 4; ++j) acc[i][j] = (f32x4){0.f, 0.f, 0.f, 0.f};
  la[0].issue(kt0, tid); lb[0].issue(kt0, tid);
  la[1].issue(kt0 + 1, tid); lb[1].issue(kt0 + 1, tid);
  const int woff = (tid >> 3) * 128 + (((tid & 7) ^ ((tid >> 3) & 7)) << 4);
#pragma unroll
  for (int i = 0; i < 4; ++i) { *(u32x4*)(sA + woff + i * 4096) = la[0].get(i, tid); *(u32x4*)(sB + woff + i * 4096) = lb[0].get(i, tid); }
  lds_barrier();
  for (int kt = 0; kt < nk; kt += 2) {
#pragma unroll
    for (int s = 0; s < 2; ++s) {
      const int t = kt + s;
      if (t + 2 < nk) { la[s].issue(kt0 + t + 2, tid); lb[s].issue(kt0 + t + 2, tid); }
      const char* cA = sA + s * 16384 + (wm * 64 + r) * 128;
      const char* cB = sB + s * 16384 + (wn * 64 + r) * 128;
#pragma unroll
      for (int ks = 0; ks < 2; ++ks) {
        const int sw = ((ks * 4 + q4) ^ (r & 7)) << 4;
        bf16x8 af[4], bfr[4];
#pragma unroll
        for (int i = 0; i < 4; ++i) { af[i] = *(const bf16x8*)(cA + i * 2048 + sw); bfr[i] = *(const bf16x8*)(cB + i * 2048 + sw); }
#pragma unroll
        for (int i = 0; i < 4; ++i)
#pragma unroll
          for (int j = 0; j < 4; ++j) acc[i][j] = MFMA16(bfr[j], af[i], acc[i][j]);
      }
      if (t + 1 < nk) {
#pragma unroll
        for (int i = 0; i < 4; ++i) { *(u32x4*)(sA + (s ^ 1) * 16384 + woff + i * 4096) = la[s ^ 1].get(i, tid); *(u32x4*)(sB + (s ^ 1) * 16384 + woff + i * 4096) = lb[s ^ 1].get(i, tid); }
      }
      lds_barrier();
    }
  }
}
DI void acc_put(char* xbuf, const f32x4 (&acc)[4][4], int tid) {
#pragma unroll
  for (int i = 0; i < 4; ++i)
#pragma unroll
    for (int j = 0; j < 4; ++j) *(f32x4*)(xbuf + ((i * 4 + j) * 256 + tid) * 16) = acc[i][j];
}
DI void acc_add(const char* xbuf, f32x4 (&acc)[4][4], int tid) {
#pragma unroll
  for (int i = 0; i < 4; ++i)
#pragma unroll
    for (int j = 0; j < 4; ++j) acc[i][j] += *(const f32x4*)(xbuf + ((i * 4 + j) * 256 + tid) * 16);
}

namespace pg8 {
#define PG8_LAS __attribute__((address_space(3)))
constexpr int BM = 256, BK = 64, HALF = 128, HTB = HALF * BK * 2, STAGE_BYTES = 8 * HTB, NXCD = 8, WGM = 8;
DI int lds_byte(int r, int c) { const int st = (r >> 4) * 2 + (c >> 5), rr = r & 15, cc = c & 31, ob = rr * 64 + cc * 2; return st * 1024 + (ob ^ (((ob >> 9) & 1) << 5)); }
DI void stage_rc(int b, int& R, int& C) { const int st = b / 1024, sb = b % 1024, swz = sb ^ (((sb >> 9) & 1) << 5); R = (st >> 1) * 16 + swz / 64; C = (st & 1) * 32 + (swz % 64) / 2; }
DI int perm32(int rho) { const int n = rho >> 4, i = rho & 15; return 8 * (i >> 2) + 4 * n + (i & 3); }
struct Unit { int pm, pn; };
struct Gemm { const bf16_t* A; const bf16_t* Bt; int M, N, K; };
struct StaticOrder {
  int nM, nN, nwg, G, c;
  DI void init(int M, int N, int G_, int c_) { nM = M / BM; nN = N / BM; nwg = nM * nN; G = G_; c = c_; }
  DI bool next(int i, Unit& u) const {
    const long L = (long)i * G + c; if (L >= nwg) return false;
    int wgid = (int)L; { const int q = nwg / NXCD, r = nwg % NXCD, xcd = wgid % NXCD, off = wgid / NXCD; wgid = (xcd < r ? xcd * (q + 1) : r * (q + 1) + (xcd - r) * q) + off; }
    const int nig = WGM * nN, gid = wgid / nig, fm = gid * WGM, gsz = (nM - fm) < WGM ? (nM - fm) : WGM;
    u.pm = fm + ((wgid % nig) % gsz); u.pn = (wgid % nig) / gsz; return true;
  }
};

template <class Epi>
DI void gemm_phase(PG8_LAS unsigned char* lds, const Gemm g, const StaticOrder& S, const Epi& E) {
  const int tid = opaque_tid(), wid = __builtin_amdgcn_readfirstlane(tid >> 6), lane = tid & 63, wr = wid >> 2, wc = wid & 3, fr = lane & 15, fq = lane >> 4;
  const int K = g.K, nt = K / BK;
  unsigned voffA[2], voffB[2];
#pragma unroll
  for (int i = 0; i < 2; ++i) { int R, C; stage_rc(tid * 16 + i * 8192, R, C); const int Rb = Epi::PERM ? ((R & ~31) + perm32(R & 31)) : R;
    voffA[i] = (unsigned)(R * K + C) * 2u; voffB[i] = (unsigned)(Rb * K + C) * 2u; }
  const size_t kstep = (size_t)(BK * 2);
  const size_t hstep = (size_t)HALF * K * 2;
  const size_t tstep = 2 * hstep;
  const unsigned ldsw = (unsigned)wid * 1024u;
  const int aoff = lds_byte(wr * 64 + fr, fq * 8), boff = lds_byte(wc * 32 + fr, fq * 8);
#define PG8_SA(b, h) (((b) * 2 + (h)) * HTB)
#define PG8_SB(b, h) ((4 + (b) * 2 + (h)) * HTB)
#define PG8_STAGE(bufoff, gbase, voff) do { _Pragma("unroll") for (int _i = 0; _i < 2; ++_i) \
    __builtin_amdgcn_global_load_lds((const unsigned*)((const char*)(gbase) + (voff)[_i]), (PG8_LAS unsigned*)(lds + (bufoff) + ldsw + _i * 8192), 16, 0, 0); } while (0)
#define PG8_LDA(dst, b, h) do { _Pragma("unroll") for (int m = 0; m < 4; ++m) _Pragma("unroll") for (int k = 0; k < 2; ++k) dst[m][k] = *(const PG8_LAS bf16x8*)(lds + PG8_SA(b, h) + aoff + m * 2048 + k * 1024); } while (0)
#define PG8_LDB(dst, b, h) do { _Pragma("unroll") for (int n = 0; n < 2; ++n) _Pragma("unroll") for (int k = 0; k < 2; ++k) dst[n][k] = *(const PG8_LAS bf16x8*)(lds + PG8_SB(b, h) + boff + n * 2048 + k * 1024); } while (0)
#define PG8_MMA(ai, bj, At, Bt) do { __builtin_amdgcn_s_setprio(1); _Pragma("unroll") for (int m = 0; m < 4; ++m) _Pragma("unroll") for (int n = 0; n < 2; ++n) _Pragma("unroll") for (int k = 0; k < 2; ++k) \
    acc[ai][bj][m][n] = __builtin_amdgcn_mfma_f32_16x16x32_bf16(Bt[n][k], At[m][k], acc[ai][bj][m][n], 0, 0, 0); __builtin_amdgcn_s_setprio(0); } while (0)
#define PG8_WAIT_V(n) asm volatile("s_waitcnt vmcnt(" #n ")" ::: "memory")
#define PG8_WAIT_L(n) asm volatile("s_waitcnt lgkmcnt(" #n ")" ::: "memory")
#define PG8_BAR __builtin_amdgcn_s_barrier()
#define PG8_SCHED __builtin_amdgcn_sched_barrier(0)
  Unit cur, nxt; int ui = 0;
  if (!S.next(0, cur)) return;
  f32x4 acc[2][2][4][2];
#pragma unroll
  for (int a = 0; a < 2; ++a)
#pragma unroll
    for (int b = 0; b < 2; ++b)
#pragma unroll
      for (int m = 0; m < 4; ++m)
#pragma unroll
        for (int n = 0; n < 2; ++n) acc[a][b][m][n] = (f32x4){0.f, 0.f, 0.f, 0.f};
  bf16x8 At[4][2], B0[2][2], B1[2][2];
  const char* cA = (const char*)g.A + (size_t)cur.pm * tstep; const char* cB = (const char*)g.Bt + (size_t)cur.pn * tstep;
  PG8_STAGE(PG8_SB(0, 0), cB, voffB); PG8_STAGE(PG8_SA(0, 0), cA, voffA); PG8_STAGE(PG8_SB(0, 1), cB + hstep, voffB); PG8_STAGE(PG8_SA(0, 1), cA + hstep, voffA);
  if (wr == 1) PG8_BAR;
  PG8_WAIT_V(4); PG8_BAR;
  PG8_STAGE(PG8_SB(1, 0), cB + kstep, voffB); PG8_STAGE(PG8_SA(1, 0), cA + kstep, voffA); PG8_STAGE(PG8_SB(1, 1), cB + hstep + kstep, voffB);
  PG8_WAIT_V(6); PG8_BAR;
  for (;;) {
    const bool has_next = S.next(ui + 1, nxt);
    const char* nA = has_next ? (const char*)g.A + (size_t)nxt.pm * tstep : cA; const char* nB = has_next ? (const char*)g.Bt + (size_t)nxt.pn * tstep : cB;
    for (int t = 0; t < nt; t += 2) {
      const bool last = (t == nt - 2);
      const char* a1 = cA + (size_t)(t + 1) * kstep;
      const char* a2 = last ? nA : cA + (size_t)(t + 2) * kstep; const char* b2 = last ? nB : cB + (size_t)(t + 2) * kstep;
      const char* a3 = a2 + kstep; const char* b3 = b2 + kstep;
      if constexpr (Epi::HAS_MID) { if (t == Epi::KMID) E.mid(acc, cur, wr, wc, fr, fq); }
      PG8_LDB(B0, 0, 0); PG8_SCHED; PG8_LDA(At, 0, 0); PG8_STAGE(PG8_SA(1, 1), a1 + hstep, voffA);
      PG8_WAIT_L(8); PG8_BAR; PG8_WAIT_L(0); PG8_MMA(0, 0, At, B0); PG8_BAR; PG8_SCHED;
      PG8_LDB(B1, 0, 1); PG8_STAGE(PG8_SB(0, 0), b2, voffB);
      PG8_BAR; PG8_WAIT_L(0); PG8_MMA(0, 1, At, B1); PG8_BAR;
      PG8_LDA(At, 0, 1); PG8_STAGE(PG8_SA(0, 0), a2, voffA);
      PG8_BAR; PG8_WAIT_L(0); PG8_MMA(1, 0, At, B0); PG8_BAR; PG8_SCHED;
      PG8_STAGE(PG8_SB(0, 1), b2 + hstep, voffB);
      PG8_WAIT_V(6); PG8_BAR; PG8_MMA(1, 1, At, B1); PG8_BAR;
      PG8_LDB(B0, 1, 0); PG8_SCHED; PG8_LDA(At, 1, 0); PG8_STAGE(PG8_SA(0, 1), a2 + hstep, voffA);
      PG8_WAIT_L(8); PG8_BAR; PG8_WAIT_L(0); PG8_MMA(0, 0, At, B0); PG8_BAR; PG8_SCHED;
      PG8_LDB(B1, 1, 1); PG8_STAGE(PG8_SB(1, 0), b3, voffB);
      PG8_BAR; PG8_WAIT_L(0); PG8_MMA(0, 1, At, B1); PG8_BAR;
      PG8_LDA(At, 1, 1); PG8_STAGE(PG8_SA(1, 0), a3, voffA);
      PG8_BAR; PG8_WAIT_L(0); PG8_MMA(1, 0, At, B0); PG8_BAR; PG8_SCHED;
      PG8_STAGE(PG8_SB(1, 1), b3 + hstep, voffB);
      PG8_WAIT_V(6); PG8_BAR; PG8_MMA(1, 1, At, B1); PG8_BAR;
    }
    E(acc, cur, wr, wc, fr, fq, ui);
    if (!has_next) break;
#pragma unroll
    for (int a = 0; a < 2; ++a)
#pragma unroll
      for (int b = 0; b < 2; ++b)
#pragma unroll
        for (int m = 0; m < 4; ++m)
#pragma unroll
          for (int n = 0; n < 2; ++n) acc[a][b][m][n] = (f32x4){0.f, 0.f, 0.f, 0.f};
    cur = nxt; cA = nA; cB = nB; ++ui;
  }
  PG8_WAIT_V(0);
  if (wr == 0) PG8_BAR;
  PG8_BAR;
#undef PG8_SA
#undef PG8_SB
#undef PG8_STAGE
#undef PG8_LDA
#undef PG8_LDB
#undef PG8_MMA
#undef PG8_WAIT_V
#undef PG8_WAIT_L
#undef PG8_BAR
#undef PG8_SCHED
}
}

DI float rstd_of(const float* SSQ, size_t row, int head) {
  const float* sp = SSQ + row * 64;
  if (head < 4) { f32x4 a = *(const f32x4*)(sp + head * 8), b = *(const f32x4*)(sp + head * 8 + 4);
    return rsqrtf((a[0] + a[1] + a[2] + a[3] + b[0] + b[1] + b[2] + b[3]) * (1.f / 256.f) + EPS); }
  f32x4 a = *(const f32x4*)(sp + 32 + (head - 4) * 4);
  return rsqrtf((a[0] + a[1] + a[2] + a[3]) * (1.f / 128.f) + EPS);
}
DI f32x4 silu4(f32x4 v) { v[0] = siluf(v[0]); v[1] = siluf(v[1]); v[2] = siluf(v[2]); v[3] = siluf(v[3]); return v; }
DI f32x4 sigm4(f32x4 v) { v[0] = sigmoidf(v[0]); v[1] = sigmoidf(v[1]); v[2] = sigmoidf(v[2]); v[3] = sigmoidf(v[3]); return v; }
DI void unpack8(u32x4 w, f32x4& a, f32x4& b) { a[0] = bflo(w[0]); a[1] = bfhi(w[0]); a[2] = bflo(w[1]); a[3] = bfhi(w[1]); b[0] = bflo(w[2]); b[1] = bfhi(w[2]); b[2] = bflo(w[3]); b[3] = bfhi(w[3]); }

struct EpiB1 {
  static constexpr bool PERM = true, HAS_MID = false; static constexpr int KMID = -1;
  char* H1; char* LF; char* GA; const float* lbp;
  DI void operator()(const f32x4 (&acc)[2][2][4][2], const pg8::Unit& u, int wr, int wc, int fr, int fq, int ui) const {
#pragma unroll
    for (int bj = 0; bj < 2; ++bj) {
      const int nt = u.pn * 2 + bj;
      if (nt >= 41) continue;
      const int c8 = nt * 128 + wc * 32 + fq * 8;
      const int row0 = u.pm * 256 + wr * 64;
      if (nt == 40) {
        if (wc == 0 && fq < 2) {
#pragma unroll
          for (int ai = 0; ai < 2; ++ai)
#pragma unroll
            for (int m = 0; m < 4; ++m) {
              float* gp = (float*)GA + (size_t)(row0 + ai * 128 + m * 16 + fr) * 16 + fq * 8;
              *(f32x4*)gp = acc[ai][bj][m][0]; *(f32x4*)(gp + 4) = acc[ai][bj][m][1];
            }
        }
        continue;
      }
      char* hb = H1 + ((size_t)row0 * LDH1) * 2;
      const unsigned hoff = (unsigned)(fr * LDH1 + c8) * 2u;
      if (nt >= 24 && nt < 32) {
        const int k = c8 - 3072;
        char* lfb = LF + ((size_t)row0 * 1024) * 2;
        const unsigned lfoff = (unsigned)(fr * 1024 + k) * 2u;
#pragma unroll
        for (int n = 0; n < 2; ++n) {
          const f32x4 lb = sigm4(*(const f32x4*)(lbp + k + 4 * n) - *(const f32x4*)(lbp + 1024 + k + 4 * n));
#pragma unroll
          for (int ai = 0; ai < 2; ++ai)
#pragma unroll
            for (int m = 0; m < 4; ++m) {
              const f32x4 s0 = sigm4(acc[ai][bj][m][n]);
              const f32x4 f0 = lb + (1.f - lb) * s0, k0 = (1.f - lb) * (1.f - s0);
              __half2 h0 = __floats2half2_rn(__logf(f0[0]), __logf(f0[1])), h1 = __floats2half2_rn(__logf(f0[2]), __logf(f0[3]));
              u32x2 hw; hw[0] = *(unsigned*)&h0; hw[1] = *(unsigned*)&h1;
              const size_t ro = (size_t)(ai * 128 + m * 16);
              *(u32x2*)(sp_(lfb + ro * 2048 + n * 8) + lfoff) = hw;
              u32x2 kw; kw[0] = pack2(k0[0], k0[1]); kw[1] = pack2(k0[2], k0[3]);
              *(u32x2*)(sp_(hb + ro * (LDH1 * 2) + n * 8) + hoff) = kw;
            }
        }
      } else {
        const int mode = (nt < 4) ? 1 : ((nt >= 16 && nt < 24) ? 2 : 0);
#pragma unroll
        for (int ai = 0; ai < 2; ++ai)
#pragma unroll
          for (int m = 0; m < 4; ++m) {
            f32x4 v0 = acc[ai][bj][m][0], v1 = acc[ai][bj][m][1];
            if (mode == 1) { v0 *= 0.08838834764831845f; v1 *= 0.08838834764831845f; }
            else if (mode == 2) { v0 = silu4(v0); v1 = silu4(v1); }
            *(u32x4*)(sp_(hb + (size_t)(ai * 128 + m * 16) * (LDH1 * 2)) + hoff) = pack8(v0, v1);
          }
      }
    }
  }
};

struct EpiB2 {
  static constexpr bool PERM = true, HAS_MID = false; static constexpr int KMID = -1;
  const char* O; char* AD; char* H2; const float* sR; const float* gn_a; const float* gn_b;
  DI void operator()(const f32x4 (&acc)[2][2][4][2], const pg8::Unit& u, int wr, int wc, int fr, int fq, int ui) const {
#pragma unroll
    for (int bj = 0; bj < 2; ++bj) {
      const int nt = u.pn * 2 + bj;
      const int c8 = nt * 128 + wc * 32 + fq * 8;
      const int row0 = u.pm * 256 + wr * 64;
      if (nt < 16) {
        const float* gp = (nt < 8) ? (gn_a + c8) : (gn_b + (c8 - 1024));
        const char* ob = O + ((size_t)row0 * 2048) * 2;
        char* adb = AD + ((size_t)row0 * 2048) * 2;
        const unsigned ooff = (unsigned)(fr * 2048 + c8) * 2u;
#pragma unroll
        for (int n = 0; n < 2; ++n) {
          const f32x4 g0 = *(const f32x4*)(gp + 4 * n);
#pragma unroll
          for (int ai = 0; ai < 2; ++ai)
#pragma unroll
            for (int m = 0; m < 4; ++m) {
              const size_t ro = (size_t)(ai * 128 + m * 16);
              const float rs = sR[(ui * 2 + bj) * 256 + wr * 64 + (int)ro + fr];
              const u32x2 ow = *(const u32x2*)(sp_(ob + ro * 4096 + n * 8) + ooff);
              f32x4 o0; o0[0] = bflo(ow[0]); o0[1] = bfhi(ow[0]); o0[2] = bflo(ow[1]); o0[3] = bfhi(ow[1]);
              const f32x4 v0 = silu4(acc[ai][bj][m][n]) * o0 * (g0 * rs);
              u32x2 w2; w2[0] = pack2(v0[0], v0[1]); w2[1] = pack2(v0[2], v0[3]);
              *(u32x2*)(sp_(adb + ro * 4096 + n * 8) + ooff) = w2;
            }
        }
      } else {
        char* hb = H2 + ((size_t)row0 * LDH2) * 2;
        const unsigned hoff = (unsigned)(fr * LDH2 + (c8 - 2048)) * 2u;
#pragma unroll
        for (int ai = 0; ai < 2; ++ai)
#pragma unroll
          for (int m = 0; m < 4; ++m)
            *(u32x4*)(sp_(hb + (size_t)(ai * 128 + m * 16) * (LDH2 * 2)) + hoff) = pack8(sigm4(acc[ai][bj][m][0]), sigm4(acc[ai][bj][m][1]));
      }
    }
  }
};

struct EpiD {
  static constexpr bool PERM = true, HAS_MID = true; static constexpr int KMID = 16;
  const char* H2; char* MG;
  DI void mid(f32x4 (&acc)[2][2][4][2], const pg8::Unit& u, int wr, int wc, int fr, int fq) const {
    const int row0 = u.pm * 256 + wr * 64;
    const char* hb = H2 + ((size_t)row0 * LDH2) * 2;
#pragma unroll
    for (int bj = 0; bj < 2; ++bj) {
      const unsigned hoff = (unsigned)(fr * LDH2 + u.pn * 256 + bj * 128 + wc * 32 + fq * 8) * 2u;
#pragma unroll
      for (int ai = 0; ai < 2; ++ai)
#pragma unroll
        for (int m = 0; m < 4; ++m) {
          const char* hp = sp_(hb + (size_t)(ai * 128 + m * 16) * (LDH2 * 2)) + hoff;
          f32x4 a0, a1, b0, b1; unpack8(*(const u32x4*)hp, a0, a1); unpack8(*(const u32x4*)(hp + 2048), b0, b1);
#pragma unroll
          for (int e = 0; e < 4; ++e) { acc[ai][bj][m][0][e] *= a0[e] * __builtin_amdgcn_rcpf(b0[e]); acc[ai][bj][m][1][e] *= a1[e] * __builtin_amdgcn_rcpf(b1[e]); }
        }
    }
  }
  DI void operator()(const f32x4 (&acc)[2][2][4][2], const pg8::Unit& u, int wr, int wc, int fr, int fq, int ui) const {
    const int row0 = u.pm * 256 + wr * 64;
    const char* hb = H2 + ((size_t)row0 * LDH2) * 2;
    char* mb = MG + ((size_t)row0 * D) * 2;
#pragma unroll
    for (int bj = 0; bj < 2; ++bj) {
      const int c8 = u.pn * 256 + bj * 128 + wc * 32 + fq * 8;
      const unsigned hoff = (unsigned)(fr * LDH2 + c8) * 2u, moff = (unsigned)(fr * D + c8) * 2u;
#pragma unroll
      for (int ai = 0; ai < 2; ++ai)
#pragma unroll
        for (int m = 0; m < 4; ++m) {
          const size_t ro = (size_t)(ai * 128 + m * 16);
          f32x4 b0, b1; unpack8(*(const u32x4*)(sp_(hb + ro * (LDH2 * 2) + 2048) + hoff), b0, b1);
          *(u32x4*)(sp_(mb + ro * (D * 2)) + moff) = pack8(acc[ai][bj][m][0] * b0, acc[ai][bj][m][1] * b1);
        }
    }
  }
};

struct EpiE {
  static constexpr bool PERM = true, HAS_MID = false; static constexpr int KMID = -1;
  const float* X; char* Z;
  DI void operator()(const f32x4 (&acc)[2][2][4][2], const pg8::Unit& u, int wr, int wc, int fr, int fq, int ui) const {
    const int row0 = u.pm * 256 + wr * 64;
    const char* xb = (const char*)(X + (size_t)row0 * D); char* zb = Z + (size_t)row0 * D * 2;
#pragma unroll
    for (int bj = 0; bj < 2; ++bj) {
      const int c8 = u.pn * 256 + bj * 128 + wc * 32 + fq * 8;
      const unsigned xoff = (unsigned)(fr * D + c8) * 4u, zoff = (unsigned)(fr * D + c8) * 2u;
#pragma unroll
      for (int ai = 0; ai < 2; ++ai)
#pragma unroll
        for (int m = 0; m < 4; ++m) {
          const size_t ro = (size_t)(ai * 128 + m * 16);
          const char* xp = sp_(xb + ro * (D * 4)) + xoff;
          const f32x4 x0 = *(const f32x4*)xp, x1 = *(const f32x4*)(xp + 16);
          *(u32x4*)(sp_(zb + ro * (D * 2)) + zoff) = pack8(x0 * ALPHA + acc[ai][bj][m][0], x1 * ALPHA + acc[ai][bj][m][1]);
        }
    }
  }
};

template <int WHICH>
DI void sample_inproj_tile(const Params& p, char* smem, int nt, int tid, bool valid, int half, char* smem_all, int mt = 128) {
  const int lane = tid & 63, wave = __builtin_amdgcn_readfirstlane(tid >> 6), wm = wave >> 1, wn = wave & 1;
  const int r = lane & 15, q4 = lane >> 4;
  const bf16_t* xb = (const bf16_t*)(p.ws + WS_XB);
  const bf16_t* win = (const bf16_t*)(p.ws + WS_WIN) + (WHICH == 0 ? 0 : (size_t)N1 * D);
  f32x4 acc[4][4];
  {
    PlainLoader la[2], lb[2];
#pragma unroll
    for (int s = 0; s < 2; ++s) { la[s].base = xb + (size_t)mt * 128 * D; la[s].ld = D; lb[s].base = win + (size_t)nt * 128 * D; lb[s].ld = D; }
    gemm128p(smem, half * 8, 8, la, lb, acc, tid);
    char* xbuf = smem_all + HALF_SMEM;
    if (half == 1) acc_put(xbuf, acc, tid);
    lds_barrier();
    if (half == 1) return;
    acc_add(xbuf, acc, tid);
  }
  const int row0 = mt * 128 + wm * 64, col0 = nt * 128 + wn * 64;
  if (WHICH == 0) {
    char* hb = p.ws + WS_H1 + ((size_t)row0 * LDH1 + col0) * 2;
    const unsigned hoff = (unsigned)(r * LDH1 + q4 * 4) * 2u;
    if (nt >= 24 && nt < 32) {
      char* lfb = p.ws + WS_LF + ((size_t)row0 * 1024 + (col0 - 3072)) * 2;
      const unsigned lfoff = (unsigned)(r * 1024 + q4 * 4) * 2u;
#pragma unroll
      for (int j = 0; j < 4; ++j) {
        const int k = col0 - 3072 + j * 16 + q4 * 4;
        f32x4 lbv = sigm4(*(const f32x4*)(p.lb_param + k) - *(const f32x4*)(p.lb_param + 1024 + k));
#pragma unroll
        for (int i = 0; i < 4; ++i) {
          f32x4 sg = sigm4(acc[i][j]);
          f32x4 f = lbv + (1.f - lbv) * sg, kh = (1.f - lbv) * (1.f - sg);
          __half2 h0 = __floats2half2_rn(__logf(f[0]), __logf(f[1])), h1 = __floats2half2_rn(__logf(f[2]), __logf(f[3]));
          u32x2 hw; hw[0] = *(unsigned*)&h0; hw[1] = *(unsigned*)&h1;
          *(u32x2*)(lfb + (size_t)(i * 16 * 1024 + j * 16) * 2 + lfoff) = hw;
          u32x2 w2; w2[0] = pack2(kh[0], kh[1]); w2[1] = pack2(kh[2], kh[3]);
          *(u32x2*)(hb + (size_t)(i * 16 * LDH1 + j * 16) * 2 + hoff) = w2;
        }
      }
    } else if (nt >= 40) {
      if (wn == 0) {
        char* gb = p.ws + WS_GA + (size_t)row0 * 64;
#pragma unroll
        for (int i = 0; i < 4; ++i) *(f32x4*)(gb + (size_t)(i * 16) * 64 + (unsigned)(r * 64 + q4 * 16)) = acc[i][0];
      }
    } else {
      const int mode = (nt < 4) ? 1 : ((nt >= 16 && nt < 24) ? 2 : 0);
#pragma unroll
      for (int i = 0; i < 4; ++i)
#pragma unroll
        for (int j = 0; j < 4; ++j) {
          f32x4 v = acc[i][j];
          if (mode == 1) v *= 0.08838834764831845f; else if (mode == 2) v = silu4(v);
          u32x2 w2; w2[0] = pack2(v[0], v[1]); w2[1] = pack2(v[2], v[3]);
          *(u32x2*)(hb + (size_t)(i * 16 * LDH1 + j * 16) * 2 + hoff) = w2;
        }
    }
  } else {
    if (nt < 16) {
      const int head = (nt < 8) ? (nt >> 1) : (4 + (nt - 8));
      const float* SSQ = (const float*)(p.ws + WS_SSQ);
      const char* ob = (const char*)(p.out + OFF_Y) + ((size_t)row0 * 2048 + col0) * 2;
      char* adb = p.ws + WS_AD + ((size_t)row0 * 2048 + col0) * 2;
      const unsigned ooff = (unsigned)(r * 2048 + q4 * 4) * 2u;
#pragma unroll
      for (int i = 0; i < 4; ++i) {
        const float rs = rstd_of(SSQ, (size_t)row0 + i * 16 + r, head);
#pragma unroll
        for (int j = 0; j < 4; ++j) {
          const int c = col0 + j * 16 + q4 * 4;
          const f32x4 gn = (nt < 8) ? *(const f32x4*)(p.gla_norm_g + c) : *(const f32x4*)(p.hgrn_norm_g + (c - 1024));
          const char* op = ob + (size_t)(i * 16 * 2048 + j * 16) * 2 + ooff;
          u32x2 ow = *(const u32x2*)op;
          f32x4 o; o[0] = bflo(ow[0]); o[1] = bfhi(ow[0]); o[2] = bflo(ow[1]); o[3] = bfhi(ow[1]);
          f32x4 v = silu4(acc[i][j]) * o * (gn * rs);
          u32x2 w2; w2[0] = pack2(v[0], v[1]); w2[1] = pack2(v[2], v[3]);
          *(u32x2*)(adb + (size_t)(i * 16 * 2048 + j * 16) * 2 + ooff) = w2;
        }
      }
    } else {
      char* hb = p.ws + WS_H2 + ((size_t)row0 * LDH2 + (col0 - 2048)) * 2;
      const unsigned hoff = (unsigned)(r * LDH2 + q4 * 4) * 2u;
#pragma unroll
      for (int i = 0; i < 4; ++i)
#pragma unroll
        for (int j = 0; j < 4; ++j) {
          f32x4 v = sigm4(acc[i][j]);
          u32x2 w2; w2[0] = pack2(v[0], v[1]); w2[1] = pack2(v[2], v[3]);
          *(u32x2*)(hb + (size_t)(i * 16 * LDH2 + j * 16) * 2 + hoff) = w2;
        }
    }
  }
}

template <int WHICH>
DI void phase_inproj(const Params& p, char* smem) {
  {
    const int tid_all = opaque_tid();
    const int half = __builtin_amdgcn_readfirstlane(tid_all >> 8), tid = tid_all & 255;
    constexpr int NTS = (WHICH == 0) ? 41 : 32;
    const int rb = gridDim.x - 1 - blockIdx.x;
    if (WHICH == 0) {
      for (int job = rb; job < 129 + 40; job += gridDim.x) {
        const int jm = (job < 129) ? job : 128, jn = (job < 129) ? 40 : job - 129;
        sample_inproj_tile<0>(p, smem + half * HALF_SMEM, jn, tid, true, half, smem, jm);
      }
    } else {
      for (int t = rb; t < NTS; t += gridDim.x) sample_inproj_tile<WHICH>(p, smem + half * HALF_SMEM, t, tid, true, half, smem);
    }
    lds_barrier();
  }
  pg8::Gemm g; g.A = (const bf16_t*)(p.ws + WS_XB); g.K = D; g.M = TP;
  pg8::StaticOrder S;
  if (WHICH == 0) {
    g.Bt = (const bf16_t*)(p.ws + WS_WIN); g.N = 20 * 256;
    S.init(g.M, g.N, gridDim.x, blockIdx.x);
    EpiB1 E; E.H1 = p.ws + WS_H1; E.LF = p.ws + WS_LF; E.GA = p.ws + WS_GA; E.lbp = p.lb_param;
    pg8::gemm_phase(( __attribute__((address_space(3))) unsigned char*)smem, g, S, E);
  } else {
    g.Bt = (const bf16_t*)(p.ws + WS_WIN) + (size_t)N1 * D; g.N = N2;
    S.init(g.M, g.N, gridDim.x, blockIdx.x);
    float* sR = (float*)(smem + pg8::STAGE_BYTES);
    {
      const int t = opaque_tid(); const int row = t & 255, slot = t >> 8;
      for (int i = 0; i < 4; ++i) {
        pg8::Unit u;
        if (S.next(i, u) && u.pn < 8) {
          const int nt = u.pn * 2 + slot;
          const int head = (nt < 8) ? (nt >> 1) : (4 + (nt - 8));
          sR[(i * 2 + slot) * 256 + row] = rstd_of((const float*)(p.ws + WS_SSQ), (size_t)u.pm * 256 + row, head);
        }
      }
      lds_barrier();
    }
    EpiB2 E; E.O = (const char*)(p.out + OFF_Y); E.AD = p.ws + WS_AD; E.H2 = p.ws + WS_H2; E.sR = sR; E.gn_a = p.gla_norm_g; E.gn_b = p.hgrn_norm_g;
    pg8::gemm_phase(( __attribute__((address_space(3))) unsigned char*)smem, g, S, E);
  }
}

constexpr int P_G = 0, P_GA = 32768, P_TOT = 36864;
constexpr int L_Q = 0, L_K = 16384, L_V = 32768, L_SB = 36864, L_O = 53248;
constexpr size_t WS_BAR = WS_END + (size_t)32 * 32 * 128 * 4;
static_assert(WS_BAR + XCD_BAR_WORDS_C * 4 <= (size_t)256 * 1024 * 1024, "bar");
constexpr size_t WS_EBG = WS_END;
static_assert(WS_EBG + (size_t)32 * 32 * 128 * 4 <= (size_t)256 * 1024 * 1024, "ebg");
typedef short s16x4 __attribute__((ext_vector_type(4)));
DI s16x4 lds_tr(const char* p) { return __builtin_amdgcn_ds_read_tr16_b64_v4i16((__attribute__((address_space(3))) s16x4*)p); }
DI bf16x8 cat8(s16x4 a, s16x4 b) { return __builtin_shufflevector(a, b, 0, 1, 2, 3, 4, 5, 6, 7); }

template <int KIND>
DI void precompute_unit(const Params& p, char* smem, int unit, int tid_in) {
  int tid = tid_in; asm volatile("" : "+v"(tid));
  const int lane = tid & 63, w = __builtin_amdgcn_readfirstlane(tid >> 6);
  const int r = lane & 15, q4 = lane >> 4;
  const int kp = tid & 63, tq = w;
  constexpr int NH = (KIND == 0) ? 4 : 8;
  const int c = unit & 31, bh = unit >> 5, h = bh % NH, b = bh / NH;
  const int qcol = (KIND == 0) ? h * 128 : 2048 + h * 128;
  const int kcol = (KIND == 0) ? 512 + h * 128 : 3072 + h * 128;
  char* H1 = p.ws + WS_H1;
  char* LF = p.ws + WS_LF;
  const size_t R = (size_t)b * SEQ + (size_t)c * 64;
  char* hb = H1 + (R + 16 * tq) * (size_t)(LDH1 * 2);
  const unsigned qo = (unsigned)(qcol + 2 * kp) * 2u, ko = (unsigned)(kcol + 2 * kp) * 2u;
  unsigned qr[16], kr[16];
#pragma unroll
  for (int i = 0; i < 16; ++i) { qr[i] = *(const unsigned*)(hb + (size_t)i * (LDH1 * 2) + qo); kr[i] = *(const unsigned*)(hb + (size_t)i * (LDH1 * 2) + ko); }
  float g0[16], g1[16];
  if (KIND == 0) {
    *(f32x4*)(smem + P_GA + tid * 16) = *(const f32x4*)(p.ws + WS_GA + R * 64 + (unsigned)(tid * 16));
    bf16x8 wB[2]; float gbias[2];
#pragma unroll
    for (int k2 = 0; k2 < 2; ++k2) {
      const int k = h * 128 + 16 * (2 * w + k2) + r;
      float wv[8]; u32x4 a;
#pragma unroll
      for (int j = 0; j < 8; ++j) wv[j] = p.w_gate_lr[(8 * (q4 & 1) + j) * 512 + k];
#pragma unroll
      for (int e = 0; e < 4; ++e) a[e] = pack2(wv[2 * e], wv[2 * e + 1]);
      wB[k2] = __builtin_bit_cast(bf16x8, a);
      gbias[k2] = p.b_gate_lr[k];
    }
    lds_barrier();
    float* sG = (float*)(smem + P_G);
#pragma unroll
    for (int tt = 0; tt < 4; ++tt) {
      const float* gp = (const float*)(smem + P_GA + (16 * tt + r) * 64 + (q4 & 1) * 32);
      f32x4 a0 = *(const f32x4*)gp, a1 = *(const f32x4*)(gp + 4);
      u32x4 hi; hi[0] = pack2(a0[0], a0[1]); hi[1] = pack2(a0[2], a0[3]); hi[2] = pack2(a1[0], a1[1]); hi[3] = pack2(a1[2], a1[3]);
      u32x4 lo;
      lo[0] = pack2(a0[0] - bflo(hi[0]), a0[1] - bfhi(hi[0])); lo[1] = pack2(a0[2] - bflo(hi[1]), a0[3] - bfhi(hi[1]));
      lo[2] = pack2(a1[0] - bflo(hi[2]), a1[1] - bfhi(hi[2])); lo[3] = pack2(a1[2] - bflo(hi[3]), a1[3] - bfhi(hi[3]));
      const bf16x8 af = __builtin_bit_cast(bf16x8, (q4 < 2) ? hi : lo);
#pragma unroll
      for (int k2 = 0; k2 < 2; ++k2) {
        f32x4 a = (f32x4){gbias[k2], gbias[k2], gbias[k2], gbias[k2]};
        a = MFMA16(af, wB[k2], a);
#pragma unroll
        for (int j = 0; j < 4; ++j) sG[(16 * tt + 4 * q4 + j) * 128 + 16 * (2 * w + k2) + r] = logsigf(a[j]) * 0.0625f;
      }
    }
    lds_barrier();
#pragma unroll
    for (int i = 0; i < 16; ++i) { float2 f = *(const float2*)(sG + (16 * tq + i) * 128 + 2 * kp); g0[i] = f.x; g1[i] = f.y; }
  } else {
    const char* lb_ = LF + (R + 16 * tq) * (size_t)2048;
    const unsigned go = (unsigned)(h * 128 + 2 * kp) * 2u;
    unsigned gr[16];
#pragma unroll
    for (int i = 0; i < 16; ++i) gr[i] = *(const unsigned*)(lb_ + (size_t)i * 2048 + go);
#pragma unroll
    for (int i = 0; i < 16; ++i) { __half2 hh = *(__half2*)&gr[i]; float2 f = __half22float2(hh); g0[i] = f.x; g1[i] = f.y; }
  }
#pragma unroll
  for (int i = 1; i < 16; ++i) { g0[i] += g0[i - 1]; g1[i] += g1[i - 1]; }
  float* sTot = (float*)(smem + P_TOT);
  *(float2*)(sTot + tq * 128 + 2 * kp) = make_float2(g0[15], g1[15]);
  lds_barrier();
  float pre0 = 0.f, pre1 = 0.f, tot0 = 0.f, tot1 = 0.f;
#pragma unroll
  for (int j = 0; j < 4; ++j) { float2 t = *(const float2*)(sTot + j * 128 + 2 * kp); tot0 += t.x; tot1 += t.y; if (j < tq) { pre0 += t.x; pre1 += t.y; } }
  if (tq == 0) {
    const float2 ev = make_float2(__expf(tot0), __expf(tot1));
    const int k = 2 * kp;
    if (KIND == 0) *(float2*)(p.ws + WS_EBG + ((size_t)(bh * 32 + c) * 128 + k) * 4) = ev;
    else *(float2*)(LF + (R + (k >> 6)) * (size_t)2048 + h * 256 + (k & 63) * 4) = ev;
  }
#pragma unroll
  for (int i = 0; i < 16; ++i) {
    const float b0 = g0[i] + pre0, b1 = g1[i] + pre1;
    const float e0 = __expf(b0), e1 = __expf(b1), n0 = __expf(-b0), n1 = __expf(-b1);
    *(unsigned*)(hb + (size_t)i * (LDH1 * 2) + qo) = pack2(bflo(qr[i]) * e0, bfhi(qr[i]) * e1);
    *(unsigned*)(hb + (size_t)i * (LDH1 * 2) + ko) = pack2(bflo(kr[i]) * n0, bfhi(kr[i]) * n1);
  }
  lds_barrier();
}

constexpr int L_BG = 57344, L_BGRED = 65536, L_BGSS = 69632;
template <int KIND>
DI void bg_setup(const Params& p, float* sv_, int idx, int tid) {
  constexpr int DV = (KIND == 0) ? 256 : 128;
  constexpr int NH = (KIND == 0) ? 4 : 8;
  const int sb = idx / NH, h = idx % NH;
  const size_t row = (size_t)TP + sb;
  const bf16_t* H1 = (const bf16_t*)(p.ws + WS_H1);
  const __half* LF = (const __half*)(p.ws + WS_LF);
  const float* GA = (const float*)(p.ws + WS_GA);
  float* sq = sv_; float* se = sv_ + 128; float* sk = sv_ + 256; float* sv = sv_ + 384;
  if (tid < 128) {
    const int k = tid;
    if (KIND == 0) {
      sq[k] = bf2f(H1[row * LDH1 + h * 128 + k]);
      sk[k] = bf2f(H1[row * LDH1 + 512 + h * 128 + k]);
      float a = p.b_gate_lr[h * 128 + k];
#pragma unroll
      for (int i = 0; i < 16; ++i) a += GA[row * 16 + i] * p.w_gate_lr[i * 512 + h * 128 + k];
      se[k] = __expf(logsigf(a) * 0.0625f);
    } else {
      sq[k] = bf2f(H1[row * LDH1 + 2048 + h * 128 + k]);
      sk[k] = bf2f(H1[row * LDH1 + 3072 + h * 128 + k]);
      se[k] = __expf(__half2float(LF[row * 1024 + h * 128 + k]));
    }
  }
  if (tid < DV) sv[tid] = bf2f(H1[row * LDH1 + ((KIND == 0) ? (1024 + h * 256) : (4096 + h * 128)) + tid]);
}
template <int KIND>
DI void bg_finish(const Params& p, char* smem, int idx, int tid, f32x4 oa) {
  constexpr int DV = (KIND == 0) ? 256 : 128;
  constexpr int NH = (KIND == 0) ? 4 : 8;
  constexpr int NG = 1024 / DV;
  const int sb = idx / NH, h = idx % NH;
  const size_t row = (size_t)TP + sb;
  float* sred = (float*)(smem + L_BGRED); float* sss = (float*)(smem + L_BGSS);
  const int col = (tid % (DV / 4)) * 4, grp = tid / (DV / 4);
  *(f32x4*)(sred + grp * DV + col) = oa;
  lds_barrier();
  float ss = 0.f;
  if (tid < DV) {
    float o = 0.f;
#pragma unroll
    for (int j = 0; j < NG; ++j) o += sred[j * DV + tid];
    bf16_t* O = (bf16_t*)(p.out + OFF_Y);
    O[row * 2048 + ((KIND == 0) ? h * 256 : 1024 + h * 128) + tid] = (bf16_t)(pack2(o, 0.f) & 0xffffu);
    ss = o * o;
  }
  ss = row16_sum(ss); ss += __shfl_xor(ss, 16); ss += __shfl_xor(ss, 32);
  if ((tid & 63) == 0) sss[tid >> 6] = ss;
  lds_barrier();
  constexpr int nsl = (KIND == 0) ? 8 : 4;
  if (tid < nsl) {
    const float tot = sss[0] + sss[1] + sss[2] + sss[3];
    ((float*)(p.ws + WS_SSQ))[row * 64 + ((KIND == 0) ? h * 8 : 32 + h * 4) + tid] = (tid == 0) ? tot : 0.f;
  }
}

DI void bg_step(const Params& p, const float* sBG, int sunit, int step, int tid, f32x4 s0, f32x4 s1, f32x4& oa) {
  const int bgi = (step < 16) ? 0 : ((step < 24) ? 1 : 2);
  const int bcl = (step < 16) ? step : ((step < 24) ? step - 16 : step - 24);
  const int bidx = (bgi == 2) ? sunit + 512 : sunit;
  float* bout = p.out + ((bgi == 0) ? OFF_GLA_S + (size_t)bidx * 32768 : OFF_HGRN_S + (size_t)bidx * 16384);
  const int bf0 = (2 * bcl) * 256 + tid, bf1 = bf0 + 256;
  const float* bv = sBG + bgi * 640;
  const int sh = (bgi == 0) ? 6 : 5;
  const int bk0 = bf0 >> sh, bk1 = bf1 >> sh, bcol = (bf0 & ((1 << sh) - 1)) * 4;
  const f32x4 vv4 = *(const f32x4*)(bv + 384 + bcol);
  const f32x4 n0 = s0 * bv[128 + bk0] + vv4 * bv[256 + bk0], n1 = s1 * bv[128 + bk1] + vv4 * bv[256 + bk1];
  __builtin_nontemporal_store(n0, (f32x4*)bout + bf0); __builtin_nontemporal_store(n1, (f32x4*)bout + bf1);
  oa += n0 * bv[bk0] + n1 * bv[bk1];
}

template <int KIND>
DI void recur_item(const Params& p, char* smem, int idx, int tid_in, int sunit) {
  int tid = tid_in; asm volatile("" : "+v"(tid));
  const int lane = tid & 63, w = __builtin_amdgcn_readfirstlane(tid >> 6);
  const int r = lane & 15, q4 = lane >> 4;
  int b, h, sl;
  if (KIND == 0) { int bh = (idx & 7) | ((idx >> 6) << 3); sl = (idx >> 3) & 7; b = bh >> 2; h = bh & 3; }
  else { int bh = (idx & 7) | ((idx >> 5) << 3); sl = (idx >> 3) & 3; b = bh >> 3; h = bh & 7; }
  const int qcol = (KIND == 0) ? h * 128 : 2048 + h * 128;
  const int kcol = (KIND == 0) ? 512 + h * 128 : 3072 + h * 128;
  const int vcol = (KIND == 0) ? 1024 + h * 256 + sl * 32 : 4096 + h * 128 + sl * 32;
  const int ocol = (KIND == 0) ? h * 256 + sl * 32 : 1024 + h * 128 + sl * 32;
  const int sidx = (KIND == 0) ? h * 8 + sl : 32 + h * 4 + sl;
  const char* H1 = p.ws + WS_H1;
  bf16_t* O = (bf16_t*)(p.out + OFF_Y);
  float* SSQ = (float*)(p.ws + WS_SSQ);
  const size_t R0 = (size_t)b * SEQ;

  for (int i = tid; i < 8192 / 16; i += 256) *(u32x4*)(smem + L_SB + i * 16) = (u32x4){0u, 0u, 0u, 0u};
  float* sBG = (float*)(smem + L_BG);
  bg_setup<0>(p, sBG, sunit, tid); bg_setup<1>(p, sBG + 640, sunit, tid); bg_setup<1>(p, sBG + 1280, sunit + 512, tid);
  f32x4 bg_oa = (f32x4){0.f, 0.f, 0.f, 0.f}, bs0 = bg_oa, bs1 = bg_oa;
  f32x4 accS[2][2];
#pragma unroll
  for (int i = 0; i < 2; ++i)
#pragma unroll
    for (int j = 0; j < 2; ++j) accS[i][j] = (f32x4){0.f, 0.f, 0.f, 0.f};

  u32x4 qv[4], kv[4], vv; f32x4 ev[2];
  const unsigned tile_off = (unsigned)((tid >> 4) * LDH1 + (tid & 15) * 8) * 2u;
  const unsigned v_off = (unsigned)((tid >> 2) * LDH1 + vcol + (tid & 3) * 8) * 2u;
  auto issue = [&](int c) {
    const char* rb = H1 + (R0 + (size_t)c * 64) * (size_t)(LDH1 * 2);
#pragma unroll
    for (int i = 0; i < 4; ++i) {
      qv[i] = *(const u32x4*)(rb + (size_t)i * 16 * (LDH1 * 2) + qcol * 2 + tile_off);
      kv[i] = *(const u32x4*)(rb + (size_t)i * 16 * (LDH1 * 2) + kcol * 2 + tile_off);
    }
    vv = *(const u32x4*)(rb + v_off);
#pragma unroll
    for (int k2 = 0; k2 < 2; ++k2) {
      const int k0 = 16 * (2 * w + k2) + 4 * q4;
      if (KIND == 0) ev[k2] = *(const f32x4*)(p.ws + WS_EBG + ((size_t)((b * 4 + h) * 32 + c) * 128 + k0) * 4);
      else ev[k2] = *(const f32x4*)(p.ws + WS_LF + (R0 + (size_t)c * 64 + (k0 >> 6)) * (size_t)2048 + h * 256 + (k0 & 63) * 4);
    }
  };
  issue(0);
  const unsigned w_off = (unsigned)((tid >> 4) * 256 + (((tid & 15) ^ ((tid >> 4) & 15)) << 4));

  for (int c = 0; c < 32; ++c) {
    const size_t R = R0 + (size_t)c * 64;
    int lid = lane; asm volatile("" : "+v"(lid));
    const int r = lid & 15, q4 = lid >> 4;
#pragma unroll
    for (int i = 0; i < 4; ++i) { *(u32x4*)(smem + L_Q + w_off + i * 4096) = qv[i]; *(u32x4*)(smem + L_K + w_off + i * 4096) = kv[i]; }
    *(u32x4*)(smem + L_V + tid * 16) = vv;
    const f32x4 eb0 = ev[0], eb1 = ev[1];
    lds_barrier();
    if (c + 1 < 32) issue(c + 1);
    const f32x4 ps0 = bs0, ps1 = bs1;
    {
      const int bgi = (c < 16) ? 0 : ((c < 24) ? 1 : 2);
      const int bcl = (c < 16) ? c : ((c < 24) ? c - 16 : c - 24);
      const int bidx = (bgi == 2) ? sunit + 512 : sunit;
      const float* bin = (bgi == 0) ? (p.state_gla + (size_t)bidx * 32768) : (p.state_hgrn + (size_t)bidx * 16384);
      const int bf0 = (2 * bcl) * 256 + tid;
      bs0 = __builtin_nontemporal_load((const f32x4*)bin + bf0); bs1 = __builtin_nontemporal_load((const f32x4*)bin + bf0 + 256);
    }
    {
      const char* sQ = smem + L_Q; const char* sK = smem + L_K; const char* sV = smem + L_V;
      const char* sSb = smem + L_SB + (c & 1) * 8192;
      char* sSbN = smem + L_SB + ((c & 1) ^ 1) * 8192;
      bf16x8 qf[4];
#pragma unroll
      for (int ks = 0; ks < 4; ++ks) qf[ks] = *(const bf16x8*)(sQ + (16 * w + r) * 256 + (((ks * 4 + q4) ^ r) << 4));
      f32x4 pt[4];
#pragma unroll
      for (int st = 0; st < 4; ++st) {
        pt[st] = (f32x4){0.f, 0.f, 0.f, 0.f};
#pragma unroll
        for (int ks = 0; ks < 4; ++ks) {
          bf16x8 kf = *(const bf16x8*)(sK + (16 * st + r) * 256 + (((ks * 4 + q4) ^ r) << 4));
          pt[st] = MFMA16(kf, qf[ks], pt[st]);
        }
      }
#pragma unroll
      for (int st = 0; st < 4; ++st)
#pragma unroll
        for (int j = 0; j < 4; ++j) {
          const bool keep = (st < w) || (st == w && (q4 * 4 + j <= r));
          pt[st][j] = keep ? pt[st][j] : 0.f;
        }
      f32x4 oacc[2];
      oacc[0] = (f32x4){0.f, 0.f, 0.f, 0.f}; oacc[1] = (f32x4){0.f, 0.f, 0.f, 0.f};
#pragma unroll
      for (int ks = 0; ks < 4; ++ks)
#pragma unroll
        for (int vt = 0; vt < 2; ++vt) {
          bf16x8 sf = *(const bf16x8*)(sSb + (16 * vt + r) * 256 + (((ks * 4 + q4) ^ r) << 4));
          oacc[vt] = MFMA16(qf[ks], sf, oacc[vt]);
        }
      const int trq = r >> 2, trp = r & 3;
#pragma unroll
      for (int pp = 0; pp < 2; ++pp) {
        {
          u32x4 pa;
          pa[0] = pack2(pt[2 * pp][0], pt[2 * pp][1]); pa[1] = pack2(pt[2 * pp][2], pt[2 * pp][3]);
          pa[2] = pack2(pt[2 * pp + 1][0], pt[2 * pp + 1][1]); pa[3] = pack2(pt[2 * pp + 1][2], pt[2 * pp + 1][3]);
          const bf16x8 paf = __builtin_bit_cast(bf16x8, pa);
#pragma unroll
          for (int vt = 0; vt < 2; ++vt) {
            const char* vp = sV + (32 * pp + 4 * q4 + trq) * 64 + (16 * vt + 4 * trp) * 2;
            const bf16x8 vb = cat8(lds_tr(vp), lds_tr(vp + 16 * 64));
            oacc[vt] = MFMA16(paf, vb, oacc[vt]);
          }
        }
      }
#pragma unroll
      for (int ks = 0; ks < 2; ++ks) {
        bf16x8 vf[2];
#pragma unroll
        for (int vt = 0; vt < 2; ++vt) {
          const char* vp = sV + (32 * ks + 8 * q4 + trq) * 64 + (16 * vt + 4 * trp) * 2;
          vf[vt] = cat8(lds_tr(vp), lds_tr(vp + 4 * 64));
        }
#pragma unroll
        for (int k2 = 0; k2 < 2; ++k2) {
          const int kt = 2 * w + k2;
          const int s0 = 32 * ks + 8 * q4 + trq;
          const int cch = 2 * kt + (trp >> 1);
          const char* kp0 = sK + s0 * 256 + ((cch ^ (s0 & 15)) << 4) + (trp & 1) * 8;
          const char* kp1 = sK + (s0 + 4) * 256 + ((cch ^ ((s0 + 4) & 15)) << 4) + (trp & 1) * 8;
          const bf16x8 kf = cat8(lds_tr(kp0), lds_tr(kp1));
#pragma unroll
          for (int vt = 0; vt < 2; ++vt) accS[k2][vt] = MFMA16(kf, vf[vt], accS[k2][vt]);
        }
      }
#pragma unroll
      for (int k2 = 0; k2 < 2; ++k2) {
        const int k0 = 16 * (2 * w + k2) + 4 * q4;
        const f32x4 eb = (k2 == 0) ? eb0 : eb1;
#pragma unroll
        for (int vt = 0; vt < 2; ++vt) {
          accS[k2][vt] *= eb;
          const int v = 16 * vt + r;
          u32x2 wv; wv[0] = pack2(accS[k2][vt][0], accS[k2][vt][1]); wv[1] = pack2(accS[k2][vt][2], accS[k2][vt][3]);
          *(u32x2*)(sSbN + v * 256 + (((k0 >> 3) ^ (v & 15)) << 4) + (k0 & 7) * 2) = wv;
        }
      }
      float ssv[4];
#pragma unroll
      for (int j = 0; j < 4; ++j) {
        const int t = 16 * w + 4 * q4 + j;
        ssv[j] = row16_sum(oacc[0][j] * oacc[0][j] + oacc[1][j] * oacc[1][j]);
        *(bf16_t*)(smem + L_O + t * 64 + r * 2) = (bf16_t)(pack2(oacc[0][j], 0.f) & 0xffffu);
        *(bf16_t*)(smem + L_O + t * 64 + (16 + r) * 2) = (bf16_t)(pack2(oacc[1][j], 0.f) & 0xffffu);
      }
      if (r < 4) {
        const float sel = (r == 0) ? ssv[0] : ((r == 1) ? ssv[1] : ((r == 2) ? ssv[2] : ssv[3]));
        SSQ[(R + 16 * w + 4 * q4 + r) * 64 + sidx] = sel;
      }
    }
    if (c > 0) bg_step(p, sBG, sunit, c - 1, tid, ps0, ps1, bg_oa);
    lds_barrier();
    *(u32x4*)((char*)O + ((R + (tid >> 2)) * 2048 + ocol + (tid & 3) * 8) * 2) = *(const u32x4*)(smem + L_O + tid * 16);
    if (c == 16) { bg_finish<0>(p, smem, sunit, tid, bg_oa); bg_oa = (f32x4){0.f, 0.f, 0.f, 0.f}; }
    else if (c == 24) { bg_finish<1>(p, smem, sunit, tid, bg_oa); bg_oa = (f32x4){0.f, 0.f, 0.f, 0.f}; }
  }
  bg_step(p, sBG, sunit, 31, tid, bs0, bs1, bg_oa);
  bg_finish<1>(p, smem, sunit + 512, tid, bg_oa);
  {
    float* So = (KIND == 0) ? (p.out + OFF_GLA_P + ((size_t)(b * 4 + h) * 128) * 256 + sl * 32)
                            : (p.out + OFF_HGRN_P + ((size_t)(b * 8 + h) * 128) * 128 + sl * 32);
    constexpr int DV = (KIND == 0) ? 256 : 128;
#pragma unroll
    for (int k2 = 0; k2 < 2; ++k2)
#pragma unroll
      for (int vt = 0; vt < 2; ++vt)
#pragma unroll
        for (int j = 0; j < 4; ++j) So[(size_t)(16 * (2 * w + k2) + 4 * q4 + j) * DV + 16 * vt + r] = accS[k2][vt][j];
  }
}

template <int KIND>
DI void sample_item(const Params& p, char* smem, int idx, int tid) {
  constexpr int DV = (KIND == 0) ? 256 : 128;
  constexpr int NH = (KIND == 0) ? 4 : 8;
  constexpr int V4 = DV / 4;
  constexpr int KR = 256 / V4;
  constexpr int NIT = 128 / KR;
  const int sb = idx / NH, h = idx % NH;
  const size_t row = (size_t)TP + sb;
  const bf16_t* H1 = (const bf16_t*)(p.ws + WS_H1);
  const __half* LF = (const __half*)(p.ws + WS_LF);
  const float* GA = (const float*)(p.ws + WS_GA);
  bf16_t* O = (bf16_t*)(p.out + OFF_Y);
  float* SSQ = (float*)(p.ws + WS_SSQ);
  float* sq = (float*)smem;
  float* se = sq + 128;
  float* sk = se + 128;
  float* sv = sk + 128;
  float* sred = sv + 256;
  float* sss = sred + 1024;
  if (tid < 128) {
    const int k = tid;
    if (KIND == 0) {
      sq[k] = bf2f(H1[row * LDH1 + h * 128 + k]);
      sk[k] = bf2f(H1[row * LDH1 + 512 + h * 128 + k]);
      float a = p.b_gate_lr[h * 128 + k];
#pragma unroll
      for (int i = 0; i < 16; ++i) a += GA[row * 16 + i] * p.w_gate_lr[i * 512 + h * 128 + k];
      se[k] = __expf(logsigf(a) * 0.0625f);
    } else {
      sq[k] = bf2f(H1[row * LDH1 + 2048 + h * 128 + k]);
      sk[k] = bf2f(H1[row * LDH1 + 3072 + h * 128 + k]);
      se[k] = __expf(__half2float(LF[row * 1024 + h * 128 + k]));
    }
  }
  if (tid < DV) sv[tid] = bf2f(H1[row * LDH1 + ((KIND == 0) ? (1024 + h * 256) : (4096 + h * 128)) + tid]);
  lds_barrier();
  const float* Sin = (KIND == 0) ? (p.state_gla + (size_t)idx * 128 * 256) : (p.state_hgrn + (size_t)idx * 128 * 128);
  float* Sout = p.out + ((KIND == 0) ? OFF_GLA_S : OFF_HGRN_S) + (size_t)idx * 128 * DV;
  const int c4 = (tid % V4) * 4, kr = tid / V4;
  const f32x4 vv = *(const f32x4*)(sv + c4);
  f32x4 oa = (f32x4){0.f, 0.f, 0.f, 0.f};
#pragma unroll 8
  for (int i = 0; i < NIT; ++i) {
    const int k = i * KR + kr;
    f32x4 s = __builtin_nontemporal_load((const f32x4*)(Sin + (size_t)k * DV + c4));
    f32x4 sn = s * se[k] + vv * sk[k];
    __builtin_nontemporal_store(sn, (f32x4*)(Sout + (size_t)k * DV + c4));
    oa += sn * sq[k];
  }
  *(f32x4*)(sred + kr * DV + c4) = oa;
  lds_barrier();
  float ss = 0.f;
  if (tid < DV) {
    float o = 0.f;
#pragma unroll
    for (int j = 0; j < KR; ++j) o += sred[j * DV + tid];
    O[row * 2048 + ((KIND == 0) ? h * 256 : 1024 + h * 128) + tid] = (bf16_t)(pack2(o, 0.f) & 0xffffu);
    ss = o * o;
  }
#pragma unroll
  for (int m = 1; m < 64; m <<= 1) ss += __shfl_xor(ss, m);
  if ((tid & 63) == 0) sss[tid >> 6] = ss;
  lds_barrier();
  if (tid < 8) {
    const int nsl = (KIND == 0) ? 8 : 4;
    if (tid < nsl) {
      float tot = sss[0] + sss[1] + sss[2] + sss[3];
      SSQ[row * 64 + ((KIND == 0) ? h * 8 : 32 + h * 4) + tid] = (tid == 0) ? tot : 0.f;
    }
  }
  lds_barrier();
}

DI void phase_precompute(const Params& p, char* smem_all) {
  {
    const int tid_all = opaque_tid();
    const int half = __builtin_amdgcn_readfirstlane(tid_all >> 8), tid = tid_all & 255;
    char* smem = smem_all + half * HALF_SMEM;
    const int nhs = gridDim.x * 2;
    for (int u = blockIdx.x * 2 + half; u < 1024; u += nhs) precompute_unit<0>(p, smem, u, tid);
    for (int u = blockIdx.x * 2 + half; u < 2048; u += nhs) precompute_unit<1>(p, smem, u, tid);
  }
}

DI void phase_recurrence(const Params& p, char* smem_all) {
  const int tid_all = opaque_tid();
  const int half = __builtin_amdgcn_readfirstlane(tid_all >> 8), tid = tid_all & 255;
  char* smem = smem_all + half * HALF_SMEM;
  for (int it = blockIdx.x; it < 256; it += gridDim.x) {
    if (half == 0) recur_item<0>(p, smem, it, tid, it * 2 + half); else recur_item<1>(p, smem, it, tid, it * 2 + half);
  }
}

DI void sample_branch_tile(const Params& p, char* smem_all, int nt, int tid, int half) {
  const int lane = tid & 63, wave = __builtin_amdgcn_readfirstlane(tid >> 6), wm = wave >> 1, wn = wave & 1;
  const int r = lane & 15, q4 = lane >> 4;
  char* smem = smem_all + half * HALF_SMEM;
  PlainLoader la[2], lb[2];
#pragma unroll
  for (int s = 0; s < 2; ++s) {
    la[s].base = (const bf16_t*)(p.ws + WS_AD) + (size_t)TP * 2048; la[s].ld = 2048;
    lb[s].base = (const bf16_t*)(p.ws + WS_WD) + (size_t)nt * 128 * 2048; lb[s].ld = 2048;
  }
  const int row0 = TP + wm * 64, col0 = nt * 128 + wn * 64;
  const char* gbase = p.ws + WS_H2 + ((size_t)row0 * LDH2 + col0) * 2;
  const unsigned goff = (unsigned)(r * LDH2 + q4 * 4) * 2u;
  f32x4 acc[4][4];
  gemm128p(smem, half * 16, 16, la, lb, acc, tid);
#pragma unroll
  for (int i = 0; i < 4; ++i)
#pragma unroll
    for (int j = 0; j < 4; ++j) {
      const char* gp = gbase + (size_t)(i * 16 * LDH2 + j * 16) * 2 + goff + half * 2048;
      u32x2 g = *(const u32x2*)gp;
      acc[i][j][0] *= bflo(g[0]); acc[i][j][1] *= bfhi(g[0]); acc[i][j][2] *= bflo(g[1]); acc[i][j][3] *= bfhi(g[1]);
    }
  char* xbuf = smem_all + HALF_SMEM;
  if (half == 1) acc_put(xbuf, acc, tid);
  lds_barrier();
  if (half == 0) {
    acc_add(xbuf, acc, tid);
    char* mb = p.ws + WS_MG + ((size_t)row0 * D + col0) * 2;
    const unsigned moff = (unsigned)(r * D + q4 * 4) * 2u;
#pragma unroll
    for (int i = 0; i < 4; ++i)
#pragma unroll
      for (int j = 0; j < 4; ++j) {
        f32x4 v = acc[i][j];
        u32x2 wv; wv[0] = pack2(v[0], v[1]); wv[1] = pack2(v[2], v[3]);
        *(u32x2*)(mb + (size_t)(i * 16 * D + j * 16) * 2 + moff) = wv;
      }
  }
}

DI void phase_branch(const Params& p, char* smem) {
  {
    const int tid_all = opaque_tid();
    const int half = __builtin_amdgcn_readfirstlane(tid_all >> 8), tid = tid_all & 255;
    const int rb = gridDim.x - 1 - blockIdx.x;
    if (rb < 8) sample_branch_tile(p, smem, rb, tid, half);
    lds_barrier();
  }
  pg8::Gemm g; g.A = (const bf16_t*)(p.ws + WS_AD); g.Bt = (const bf16_t*)(p.ws + WS_WD); g.K = 2048; g.M = TP; g.N = D;
  pg8::StaticOrder S; S.init(g.M, g.N, gridDim.x, blockIdx.x);
  EpiD E; E.H2 = p.ws + WS_H2; E.MG = p.ws + WS_MG;
  pg8::gemm_phase(( __attribute__((address_space(3))) unsigned char*)smem, g, S, E);
}

DI void sample_outproj_tile(const Params& p, char* smem_all, int nt, int tid, int half) {
  const int lane = tid & 63, wave = __builtin_amdgcn_readfirstlane(tid >> 6), wm = wave >> 1, wn = wave & 1;
  const int r = lane & 15, q4 = lane >> 4;
  char* smem = smem_all + half * HALF_SMEM;
  PlainLoader la[2], lb[2];
#pragma unroll
  for (int s = 0; s < 2; ++s) {
    la[s].base = (const bf16_t*)(p.ws + WS_MG) + (size_t)TP * D; la[s].ld = D;
    lb[s].base = (const bf16_t*)(p.ws + WS_WO) + (size_t)nt * 128 * D; lb[s].ld = D;
  }
  f32x4 acc[4][4];
  gemm128p(smem, half * 8, 8, la, lb, acc, tid);
  char* xbuf = smem_all + HALF_SMEM;
  if (half == 1) acc_put(xbuf, acc, tid);
  lds_barrier();
  if (half == 0) {
    acc_add(xbuf, acc, tid);
    const int row0 = wm * 64, col0 = nt * 128 + wn * 64;
    const char* xbase = (const char*)(p.x_sample + (size_t)row0 * D + col0);
    char* zbase = p.ws + WS_AD + ((size_t)(TP + row0) * D + col0) * 2;
    const unsigned xo = (unsigned)(r * D + q4 * 4) * 4u, zo = (unsigned)(r * D + q4 * 4) * 2u;
#pragma unroll
    for (int i = 0; i < 4; ++i)
#pragma unroll
      for (int j = 0; j < 4; ++j) {
        const f32x4 xv = *(const f32x4*)(xbase + (size_t)(i * 16 * D + j * 16) * 4 + xo);
        const f32x4 z = xv * ALPHA + acc[i][j];
        u32x2 w2; w2[0] = pack2(z[0], z[1]); w2[1] = pack2(z[2], z[3]);
        *(u32x2*)(zbase + (size_t)(i * 16 * D + j * 16) * 2 + zo) = w2;
      }
  }
}

DI void phase_outproj(const Params& p, char* smem) {
  {
    const int tid_all = opaque_tid();
    const int half = __builtin_amdgcn_readfirstlane(tid_all >> 8), tid = tid_all & 255;
    const int rb = gridDim.x - 1 - blockIdx.x;
    if (rb < 8) sample_outproj_tile(p, smem, rb, tid, half);
    lds_barrier();
  }
  pg8::Gemm g; g.A = (const bf16_t*)(p.ws + WS_MG); g.Bt = (const bf16_t*)(p.ws + WS_WO); g.K = D; g.M = TP; g.N = D;
  pg8::StaticOrder S; S.init(g.M, g.N, gridDim.x, blockIdx.x);
  EpiE E; E.X = p.x_prompt; E.Z = p.ws + WS_AD;
  pg8::gemm_phase(( __attribute__((address_space(3))) unsigned char*)smem, g, S, E);
}

DI void phase_ln(const Params& p) {
  const int tid = opaque_tid(), lane = tid & 63, wave = tid >> 6;
  float* Y = p.out + OFF_Y;
  const char* Z = p.ws + WS_AD;
  for (int row = blockIdx.x * 8 + wave; row < TT; row += gridDim.x * 8) {
    const char* zr = Z + (size_t)row * D * 2;
    f32x4 v[4]; float s = 0.f;
    unpack8(*(const u32x4*)(zr + lane * 16), v[0], v[1]);
    unpack8(*(const u32x4*)(zr + 1024 + lane * 16), v[2], v[3]);
#pragma unroll
    for (int i = 0; i < 4; ++i) s += v[i][0] + v[i][1] + v[i][2] + v[i][3];
    s = row16_sum(s); s += __shfl_xor(s, 16); s += __shfl_xor(s, 32);
    const float mu = s * (1.f / 1024.f);
    float q = 0.f;
#pragma unroll
    for (int i = 0; i < 4; ++i) { v[i] -= mu; q += v[i][0] * v[i][0] + v[i][1] * v[i][1] + v[i][2] * v[i][2] + v[i][3] * v[i][3]; }
    q = row16_sum(q); q += __shfl_xor(q, 16); q += __shfl_xor(q, 32);
    const float rs = rsqrtf(q * (1.f / 1024.f) + EPS);
    float* yr = Y + (size_t)row * D;
#pragma unroll
    for (int i = 0; i < 4; ++i) {
      const int c = (i >> 1) * 512 + lane * 8 + (i & 1) * 4;
      f32x4 g = *(const f32x4*)(p.ln_g + c), bb = *(const f32x4*)(p.ln_b + c);
      *(f32x4*)(yr + c) = v[i] * rs * g + bb;
    }
  }
}

#define XB_TMO      128
#define XB_XCNT(j)  (256  + 64 * (j))
#define XB_XSUB(j)  (1280 + 64 * (j))
#define XB_XGEN(j)  (2304 + 64 * (j))
#define XB_TOP      3328
#define XB_TOPGEN   3392
#define XCD_BAR_WORDS 3456
#define XB_SPIN_CAP (1u << 18)
#define LAS3 __attribute__((address_space(3)))
DI unsigned xb_ld(unsigned* p)              { return __hip_atomic_load(p, __ATOMIC_RELAXED, __HIP_MEMORY_SCOPE_AGENT); }
DI unsigned xb_add(unsigned* p, unsigned v) { return __hip_atomic_fetch_add(p, v, __ATOMIC_RELAXED, __HIP_MEMORY_SCOPE_AGENT); }
DI unsigned xb_xcc_id() { return (unsigned)__builtin_amdgcn_s_getreg((3 << 11) | 20) & 0xFu; }
#define XB_SPIN(cond, bar) do { unsigned _sp = 0; while (cond) { __builtin_amdgcn_s_sleep(1); \
    if ((++_sp & 255u) == 0u) { if (xb_ld(&(bar)[XB_TMO])) break; if (_sp > XB_SPIN_CAP) { atomicAdd(&(bar)[XB_TMO], 1u); break; } } } } while (0)
struct XcdBarrier { unsigned* bar; unsigned x; volatile LAS3 unsigned* st; };
DI XcdBarrier xcd_barrier_post(unsigned* bar, volatile LAS3 unsigned* st) {
  XcdBarrier b; b.bar = bar; b.x = xb_xcc_id(); b.st = st;
  if (threadIdx.x == 0) (void)xb_add(&bar[XB_XCNT(b.x)], 1u);
  return b;
}
DI void xcd_barrier_complete(unsigned* bar, unsigned x, unsigned& nloc, unsigned& nx) {
  const unsigned G = gridDim.x * gridDim.y * gridDim.z;
  unsigned sum, cnt, mine, sp = 0u;
  for (;;) {
    sum = 0u; cnt = 0u; mine = 0u;
#pragma unroll
    for (unsigned j = 0; j < 16; ++j) { const unsigned c = xb_ld(&bar[XB_XCNT(j)]); sum += c; cnt += (c > 0u) ? 1u : 0u; mine = (j == x) ? c : mine; }
    if (sum == G) break;
    __builtin_amdgcn_s_sleep(1);
    if ((++sp & 255u) == 0u) { if (xb_ld(&bar[XB_TMO])) break; if (sp > XB_SPIN_CAP) { atomicAdd(&bar[XB_TMO], 1u); break; } }
  }
  nloc = mine > 0u ? mine : 1u; nx = cnt > 0u ? cnt : 1u;
}
DI void xcd_barrier(const XcdBarrier& b) {
  asm volatile("s_waitcnt vmcnt(0)" ::: "memory");
  __syncthreads();
  if (threadIdx.x == 0) {
    unsigned* bar = b.bar;
    __builtin_amdgcn_s_waitcnt(0);
    unsigned nloc = b.st[0], nx = b.st[1];
    if (nloc == 0u) { xcd_barrier_complete(bar, b.x, nloc, nx); b.st[0] = nloc; b.st[1] = nx; }
    const unsigned old = xb_add(&bar[XB_XSUB(b.x)], 1u);
    const unsigned gen = old / nloc;
    if (old + 1u == (gen + 1u) * nloc) {
      __builtin_amdgcn_fence(__ATOMIC_RELEASE, "agent");
      asm volatile("s_waitcnt vmcnt(0)" ::: "memory");
      const unsigned og = xb_add(&bar[XB_TOP], 1u);
      const unsigned tg = og / nx;
      if (og + 1u == (tg + 1u) * nx) xb_add(&bar[XB_TOPGEN], 1u);
      else XB_SPIN(xb_ld(&bar[XB_TOPGEN]) == tg, bar);
      __builtin_amdgcn_fence(__ATOMIC_ACQUIRE, "agent");
      xb_add(&bar[XB_XGEN(b.x)], 1u);
      asm volatile("s_waitcnt vmcnt(0)" ::: "memory");
    } else {
      XB_SPIN(xb_ld(&bar[XB_XGEN(b.x)]) == gen, bar);
      __builtin_amdgcn_fence(__ATOMIC_ACQUIRE, "agent");
      asm volatile("s_waitcnt vmcnt(0)" ::: "memory");
    }
  }
  __syncthreads();
}

#define GRID_SYNC() do { asm volatile("s_waitcnt vmcnt(0) lgkmcnt(0)" ::: "memory"); grid.sync(); __builtin_amdgcn_fence(__ATOMIC_ACQUIRE, "agent"); asm volatile("s_waitcnt vmcnt(0)" ::: "memory"); } while (0)
__global__ void __launch_bounds__(512, 2) fwd_megakernel(Params p) {
  extern __shared__ __attribute__((aligned(16))) char smem[];
  cg::grid_group grid = cg::this_grid();
  volatile LAS3 unsigned* xst = (volatile LAS3 unsigned*)(smem + SMEM_BYTES - 16);
  if (threadIdx.x == 0) { xst[0] = 0u; xst[1] = 0u; xst[2] = 0u; xst[3] = 0u; }
  __syncthreads();
  const XcdBarrier xb = xcd_barrier_post((unsigned*)(p.ws + WS_BAR), xst);
  if (p.out == nullptr) grid.sync();
  phase_convert(p, smem);
  xcd_barrier(xb);
  phase_inproj<0>(p, smem);
  xcd_barrier(xb);
  phase_precompute(p, smem);
  xcd_barrier(xb);
  phase_recurrence(p, smem);
  xcd_barrier(xb);
  phase_inproj<1>(p, smem);
  xcd_barrier(xb);
  phase_branch(p, smem);
  xcd_barrier(xb);
  phase_outproj(p, smem);
  xcd_barrier(xb);
  phase_ln(p);
}

extern "C" void kernel_launch(void* const* d_in, const int* in_sizes, int n_in, void* d_out, int out_size,
                              void* d_ws, size_t ws_size, hipStream_t stream) {
  static int grid_blocks = 0;
  if (!grid_blocks) {
    int dev = 0, cus = 0, per_cu = 0;
    (void)hipGetDevice(&dev);
    (void)hipDeviceGetAttribute(&cus, hipDeviceAttributeMultiprocessorCount, dev);
    (void)hipFuncSetAttribute((const void*)fwd_megakernel, hipFuncAttributeMaxDynamicSharedMemorySize, SMEM_BYTES);
    (void)hipOccupancyMaxActiveBlocksPerMultiprocessor(&per_cu, fwd_megakernel, 512, SMEM_BYTES);
    if (per_cu > 1) per_cu = 1;
    if (per_cu < 1) per_cu = 1;
    grid_blocks = cus * per_cu;
    if (grid_blocks > 256) grid_blocks = 256;
    grid_blocks &= ~7;
  }
  Params p{};
  p.x_prompt = (const float*)d_in[0]; p.x_sample = (const float*)d_in[1];
  p.state_gla = (const float*)d_in[2]; p.state_hgrn = (const float*)d_in[3];
  p.w_in = (const float*)d_in[4]; p.w_gate_lr = (const float*)d_in[5]; p.b_gate_lr = (const float*)d_in[6];
  p.gla_norm_g = (const float*)d_in[7]; p.w_br_gla = (const float*)d_in[8]; p.lb_param = (const float*)d_in[9];
  p.hgrn_norm_g = (const float*)d_in[10]; p.w_br_hgrn = (const float*)d_in[11]; p.w_out = (const float*)d_in[12];
  p.ln_g = (const float*)d_in[13]; p.ln_b = (const float*)d_in[14];
  p.out = (float*)d_out; p.ws = (char*)d_ws;
  (void)hipMemsetAsync((char*)d_ws + WS_BAR, 0, (size_t)XCD_BAR_WORDS * 4, stream);
  void* args[] = {&p};
  hipError_t e = hipLaunchCooperativeKernel((void*)fwd_megakernel, dim3(grid_blocks), dim3(512), args, SMEM_BYTES, stream);
  if (e != hipSuccess) fprintf(stderr, "cooperative launch failed: %s (grid %d)\n", hipGetErrorString(e), grid_blocks);
}
```
